# Optimizing an MI355X kernel written in HIP

```python
import math
import jax, jax.numpy as jnp
from jax import lax
import numpy as np

D_MODEL = 1024
BATCH = 8
SEQ = 2048
DEPTH = 4

N_META = 16
N_HEADS = 16
HEAD_DIM = D_MODEL // N_HEADS
Q_BLOCK = 128
CONV_W = 3
D_FF = 4 * D_MODEL
N_MIXERS = 2
N_CONV_LAYERS = (DEPTH + 1) // 2
N_ATTN_LAYERS = DEPTH // 2
RMS_EPS = 1e-6

kernel_name = "hybrid_shortconv_stickbreaking_sqrelu"


def rmsnorm(x, g):
    xf = x.astype(jnp.float32)
    y = xf * lax.rsqrt(jnp.mean(xf * xf, axis=-1, keepdims=True) + RMS_EPS)
    return (y * g.astype(jnp.float32)).astype(x.dtype)


def causal_depthwise_conv(u, conv_w):
    L = u.shape[1]
    up = jnp.pad(u, ((0, 0), (CONV_W - 1, 0), (0, 0)))
    w = conv_w.astype(u.dtype)
    out = up[:, 0:L] * w[0]
    for k in range(1, CONV_W):
        out = out + up[:, k:k + L] * w[k]
    return out


def short_conv_mixer(h, w_in, conv_w, w_out):
    proj = jnp.einsum('bld,de->ble', h, w_in)
    gate_b = proj[..., :D_MODEL]
    gate_c = proj[..., D_MODEL:2 * D_MODEL]
    val = proj[..., 2 * D_MODEL:]
    conv = causal_depthwise_conv(gate_c * val, conv_w)
    return jnp.einsum('bld,de->ble', gate_b * conv, w_out)


def _block_bounds(L):
    bounds = [(0, N_META)]
    n_real = L - N_META
    n_blk = -(-n_real // Q_BLOCK)
    for i in range(n_blk):
        q0 = N_META + i * Q_BLOCK
        bounds.append((q0, min(q0 + Q_BLOCK, L)))
    return bounds


def stick_breaking_attention(q, k, v):
    L = q.shape[2]
    scale = 1.0 / math.sqrt(HEAD_DIM)
    outs = []
    for (q0, q1) in _block_bounds(L):
        qb = q[:, :, q0:q1]
        kb = k[:, :, :q1]
        vb = v[:, :, :q1]
        z = jnp.einsum('bhqd,bhkd->bhqk', qb, kb).astype(jnp.float32) * scale
        t_pos = q0 + jnp.arange(q1 - q0)[:, None]
        s_pos = jnp.arange(q1)[None, :]
        causal = s_pos < t_pos
        log_beta = jax.nn.log_sigmoid(z)
        log_1m = jnp.where(causal, jax.nn.log_sigmoid(-z), 0.0)
        tail = jnp.sum(log_1m, axis=-1, keepdims=True) - jnp.cumsum(log_1m, axis=-1)
        w = jnp.where(causal, jnp.exp(log_beta + tail), 0.0)
        outs.append(jnp.einsum('bhqk,bhkd->bhqd', w.astype(vb.dtype), vb))
    return jnp.concatenate(outs, axis=2)


def stick_breaking_mixer(h, w_qkv, w_out):
    B, L, _ = h.shape
    qkv = jnp.einsum('bld,de->ble', h, w_qkv)
    qkv = qkv.reshape(B, L, 3, N_HEADS, HEAD_DIM)
    q = jnp.transpose(qkv[:, :, 0], (0, 2, 1, 3))
    k = jnp.transpose(qkv[:, :, 1], (0, 2, 1, 3))
    v = jnp.transpose(qkv[:, :, 2], (0, 2, 1, 3))
    o = stick_breaking_attention(q, k, v)
    o = jnp.transpose(o, (0, 2, 1, 3)).reshape(B, L, D_MODEL)
    return jnp.einsum('bld,de->ble', o, w_out)


def sqrelu_mlp(h, w1, w2):
    a = jnp.einsum('bld,df->blf', h, w1)
    a = jnp.square(jax.nn.relu(a))
    return jnp.einsum('blf,fd->bld', a, w2)


def setup_inputs(seed: int = 0) -> dict:
    key = jax.random.key(seed)
    ks = jax.random.split(key, 16)
    f32 = jnp.float32
    D = D_MODEL

    def nrm(k, shape, scale):
        return jax.random.normal(k, shape, f32) * scale

    return {
        "x": nrm(ks[0], (BATCH, SEQ, D), 1.0),
        "meta_tokens": nrm(ks[1], (N_META, D), 1.0),
        "conv_norm": 1.0 + nrm(ks[2], (N_CONV_LAYERS, D), 0.01),
        "conv_w_in": nrm(ks[3], (N_CONV_LAYERS, D, 3 * D), D ** -0.5),
        "conv_w": nrm(ks[4], (N_CONV_LAYERS, CONV_W, D), CONV_W ** -0.5),
        "conv_w_out": nrm(ks[5], (N_CONV_LAYERS, D, D), D ** -0.5),
        "attn_norm": 1.0 + nrm(ks[6], (N_ATTN_LAYERS, D), 0.01),
        "attn_w_qkv": nrm(ks[7], (N_ATTN_LAYERS, D, 3 * D), D ** -0.5),
        "attn_w_out": nrm(ks[8], (N_ATTN_LAYERS, D, D), D ** -0.5),
        "mlp_norm": 1.0 + nrm(ks[9], (DEPTH, D), 0.01),
        "mlp_w1": nrm(ks[10], (DEPTH, D, D_FF), D ** -0.5),
        "mlp_w2": nrm(ks[11], (DEPTH, D_FF, D), D_FF ** -0.5),
        "final_norm": 1.0 + nrm(ks[12], (D,), 0.01),
    }


def reference(x, meta_tokens, conv_norm, conv_w_in, conv_w, conv_w_out,
              attn_norm, attn_w_qkv, attn_w_out, mlp_norm, mlp_w1, mlp_w2,
              final_norm):
    B = x.shape[0]
    meta = jnp.broadcast_to(meta_tokens.astype(x.dtype)[None], (B, N_META, D_MODEL))
    h = jnp.concatenate([meta, x], axis=1)
    for i in range(DEPTH):
        j = i // N_MIXERS
        if i % N_MIXERS == 0:
            h = h + short_conv_mixer(rmsnorm(h, conv_norm[j]), conv_w_in[j],
                                     conv_w[j], conv_w_out[j])
        else:
            h = h + stick_breaking_mixer(rmsnorm(h, attn_norm[j]), attn_w_qkv[j],
                                         attn_w_out[j])
        h = h + sqrelu_mlp(rmsnorm(h, mlp_norm[i]), mlp_w1[i], mlp_w2[i])
    h = rmsnorm(h, final_norm)
    return h[:, N_META:]
```

```cpp
#include <hip/hip_runtime.h>
#include <hip/hip_cooperative_groups.h>
#include <cstdio>
#include <cstdint>
#include <cmath>
namespace cg = cooperative_groups;
namespace pg8 {
#define PG8_LAS __attribute__((address_space(3)))
typedef unsigned short bf16_t;
typedef short bf16x8 __attribute__((ext_vector_type(8)));
typedef float f32x4 __attribute__((ext_vector_type(4)));
typedef unsigned u32x4 __attribute__((ext_vector_type(4)));
constexpr int BM = 256, BK = 64, HALF = 128, HTB = HALF * BK * 2  , STAGE_BYTES = 8 * HTB, NXCD = 8, WGM = 8;

__host__ __device__ __forceinline__ int lds_byte(int r, int c) { const int st = (r >> 4) * 2 + (c >> 5), rr = r & 15, cc = c & 31, ob = rr * 64 + cc * 2; return st * 1024 + (ob ^ (((ob >> 9) & 1) << 5)); }
__host__ __device__ __forceinline__ void stage_rc(int b, int& R, int& C) { const int st = b / 1024, sb = b % 1024, swz = sb ^ (((sb >> 9) & 1) << 5); R = (st >> 1) * 16 + swz / 64; C = (st & 1) * 32 + (swz % 64) / 2; }
__host__ __device__ __forceinline__ int perm32(int rho) { const int n = rho >> 4, i = rho & 15; return 8 * (i >> 2) + 4 * n + (i & 3); }

struct Unit { int pm, pn; };
struct Gemm { const bf16_t* A; const bf16_t* Bt; int M, N, K; };

struct StaticOrder {
    int nM, nN, nwg, G, c;
    __host__ __device__ void init(int M, int N, int G_, int c_) { nM = M / BM; nN = N / BM; nwg = nM * nN; G = G_; c = c_; }
    __host__ __device__ bool next(int i, Unit& u) const {
        const long L = (long)i * G + c; if (L >= nwg) return false;
        int wgid = (int)L; { const int q = nwg / NXCD, r = nwg % NXCD, xcd = wgid % NXCD, off = wgid / NXCD; wgid = (xcd < r ? xcd * (q + 1) : r * (q + 1) + (xcd - r) * q) + off; }
        const int nig = WGM * nN, gid = wgid / nig, fm = gid * WGM, gsz = (nM - fm) < WGM ? (nM - fm) : WGM;
        u.pm = fm + ((wgid % nig) % gsz); u.pn = (wgid % nig) / gsz; return true;
    }
    __device__ __forceinline__ void a_ready(const Unit&) const {}
    __device__ __forceinline__ void done(const Unit&) const {}
};

typedef float f32x2_t __attribute__((ext_vector_type(2))); typedef __bf16 bf16x2_t __attribute__((ext_vector_type(2)));
__device__ __forceinline__ unsigned cvt_pk_bf16(float lo, float hi) { f32x2_t v = {lo, hi}; bf16x2_t b = __builtin_convertvector(v, bf16x2_t); return __builtin_bit_cast(unsigned, b); }
template <class Epi, class Sched, bool ALIGN_EPI = false, bool SP2 = false, class Pre>
__device__ __forceinline__ void gemm_phase(PG8_LAS unsigned char* lds, const Gemm g, const Sched& S, const Epi& E, const int wv0  , const Pre& pre  ) {
    int tid_; asm volatile("v_mbcnt_lo_u32_b32 %0, -1, 0\n\tv_mbcnt_hi_u32_b32 %0, -1, %0" : "=v"(tid_)); const int tid = tid_ + 64 * wv0, wid = __builtin_amdgcn_readfirstlane(tid >> 6), lane = tid & 63, wr = wid >> 2, wc = wid & 3, fr = lane & 15, fq = lane >> 4;
    const int K = g.K, nt = K / BK;
    unsigned voffA[2], voffB[2];
#pragma unroll
    for (int i = 0; i < 2; ++i) { int R, C; stage_rc(tid * 16 + i * 8192, R, C); const int Rb = Epi::PERM ? ((R & ~31) + perm32(R & 31)) : R;
        voffA[i] = (unsigned)(R * K + C) * 2u; voffB[i] = (unsigned)(Rb * K + C) * 2u; }
    const size_t kstep = (size_t)(BK * 2);
    const size_t hstep = (size_t)HALF * K * 2;
    const size_t tstep = 2 * hstep;
    const unsigned ldsw = (unsigned)wid * 1024u;
    const int aoff = lds_byte(wr * 64 + fr, fq * 8), boff = lds_byte(wc * 32 + fr, fq * 8);
#define PG8_SA(b, h) (((b) * 2 + (h)) * HTB)
#define PG8_SB(b, h) ((4 + (b) * 2 + (h)) * HTB)
#define PG8_STAGE(bufoff, gbase, voff) do { _Pragma("unroll") for (int _i = 0; _i < 2; ++_i) \
        __builtin_amdgcn_global_load_lds((const unsigned*)((const char*)(gbase) + (voff)[_i]), (PG8_LAS unsigned*)(lds + (bufoff) + ldsw + _i * 8192), 16, 0, 0); } while (0)
#define PG8_LDA(dst, b, h) do { _Pragma("unroll") for (int m = 0; m < 4; ++m) _Pragma("unroll") for (int k = 0; k < 2; ++k) dst[m][k] = *(const PG8_LAS bf16x8*)(lds + PG8_SA(b, h) + aoff + m * 2048 + k * 1024); } while (0)
#define PG8_LDB(dst, b, h) do { _Pragma("unroll") for (int n = 0; n < 2; ++n) _Pragma("unroll") for (int k = 0; k < 2; ++k) dst[n][k] = *(const PG8_LAS bf16x8*)(lds + PG8_SB(b, h) + boff + n * 2048 + k * 1024); } while (0)
#define PG8_MMA(ai, bj, At, Bt) do { __builtin_amdgcn_s_setprio(1); _Pragma("unroll") for (int m = 0; m < 4; ++m) _Pragma("unroll") for (int n = 0; n < 2; ++n) _Pragma("unroll") for (int k = 0; k < 2; ++k) \
        acc[ai][bj][m][n] = __builtin_amdgcn_mfma_f32_16x16x32_bf16(Bt[n][k], At[m][k], acc[ai][bj][m][n], 0, 0, 0); __builtin_amdgcn_s_setprio(0); } while (0)
#define PG8_WAIT_V(n) asm volatile("s_waitcnt vmcnt(" #n ")" ::: "memory")
#define PG8_WAIT_L(n) asm volatile("s_waitcnt lgkmcnt(" #n ")" ::: "memory")
#define PG8_BAR __builtin_amdgcn_s_barrier()
#define PG8_SCHED __builtin_amdgcn_sched_barrier(0)
    Unit cur, nxt; int ui = 0;
    if (!S.next(0, cur)) return;
    f32x4 acc[2][2][4][2];
#pragma unroll
    for (int a = 0; a < 2; ++a)
#pragma unroll
        for (int b = 0; b < 2; ++b)
#pragma unroll
            for (int m = 0; m < 4; ++m)
#pragma unroll
                for (int n = 0; n < 2; ++n) acc[a][b][m][n] = (f32x4){0.f, 0.f, 0.f, 0.f};
    bf16x8 At[4][2], B0[2][2], B1[2][2];
    const char* cA = (const char*)g.A + (size_t)cur.pm * tstep; const char* cB = (const char*)g.Bt + (size_t)cur.pn * tstep;
    S.a_ready(cur);
    if constexpr (SP2) {
        PG8_STAGE(PG8_SB(0, 0), cB, voffB); PG8_STAGE(PG8_SB(0, 1), cB + hstep, voffB); PG8_STAGE(PG8_SA(0, 0), cA, voffA); PG8_STAGE(PG8_SA(0, 1), cA + hstep, voffA);
        pre();
        if (wr == 1) PG8_BAR;
        PG8_WAIT_V(2); PG8_BAR;
        PG8_STAGE(PG8_SB(1, 0), cB + kstep, voffB); PG8_STAGE(PG8_SA(1, 0), cA + kstep, voffA); PG8_STAGE(PG8_SB(1, 1), cB + hstep + kstep, voffB);
        PG8_WAIT_V(6); PG8_BAR;
    } else {
        PG8_STAGE(PG8_SB(0, 0), cB, voffB); PG8_STAGE(PG8_SA(0, 0), cA, voffA); PG8_STAGE(PG8_SB(0, 1), cB + hstep, voffB); PG8_STAGE(PG8_SA(0, 1), cA + hstep, voffA);
        if (wr == 1) PG8_BAR;
        PG8_WAIT_V(4); PG8_BAR;
        PG8_STAGE(PG8_SB(1, 0), cB + kstep, voffB); PG8_STAGE(PG8_SA(1, 0), cA + kstep, voffA); PG8_STAGE(PG8_SB(1, 1), cB + hstep + kstep, voffB);
        PG8_WAIT_V(6); PG8_BAR;
    }
    for (;;) {
        const bool has_next = S.next(ui + 1, nxt);
        const char* nA = has_next ? (const char*)g.A + (size_t)nxt.pm * tstep : cA; const char* nB = has_next ? (const char*)g.Bt + (size_t)nxt.pn * tstep : cB;
        for (int t = 0; t < nt; t += 2) {
            const bool last = (t == nt - 2);
            const char* a1 = cA + (size_t)(t + 1) * kstep;
            const char* a2 = last ? nA : cA + (size_t)(t + 2) * kstep; const char* b2 = last ? nB : cB + (size_t)(t + 2) * kstep;
            const char* a3 = a2 + kstep; const char* b3 = b2 + kstep;
            if (last && has_next) S.a_ready(nxt);
            if constexpr (SP2) {
            PG8_LDB(B0, 0, 0); PG8_LDB(B1, 0, 1); PG8_SCHED; PG8_LDA(At, 0, 0); PG8_STAGE(PG8_SA(1, 1), a1 + hstep, voffA);
            PG8_WAIT_V(8); PG8_WAIT_L(0); PG8_BAR; PG8_MMA(0, 0, At, B0); PG8_MMA(0, 1, At, B1); PG8_BAR; PG8_SCHED;
            PG8_LDA(At, 0, 1); PG8_STAGE(PG8_SB(0, 0), b2, voffB); PG8_STAGE(PG8_SB(0, 1), b2 + hstep, voffB); PG8_STAGE(PG8_SA(0, 0), a2, voffA);
            PG8_WAIT_V(8); PG8_WAIT_L(0); PG8_BAR; PG8_MMA(1, 0, At, B0); PG8_MMA(1, 1, At, B1); PG8_BAR; PG8_SCHED;
            PG8_LDB(B0, 1, 0); PG8_LDB(B1, 1, 1); PG8_SCHED; PG8_LDA(At, 1, 0); PG8_STAGE(PG8_SA(0, 1), a2 + hstep, voffA);
            PG8_WAIT_V(8); PG8_WAIT_L(0); PG8_BAR; PG8_MMA(0, 0, At, B0); PG8_MMA(0, 1, At, B1); PG8_BAR; PG8_SCHED;
            PG8_LDA(At, 1, 1); PG8_STAGE(PG8_SB(1, 0), b3, voffB); PG8_STAGE(PG8_SB(1, 1), b3 + hstep, voffB); PG8_STAGE(PG8_SA(1, 0), a3, voffA);
            PG8_WAIT_V(8); PG8_WAIT_L(0); PG8_BAR; PG8_MMA(1, 0, At, B0); PG8_MMA(1, 1, At, B1); PG8_BAR; PG8_SCHED;
            } else {
            PG8_LDB(B0, 0, 0); PG8_SCHED; PG8_LDA(At, 0, 0); PG8_STAGE(PG8_SA(1, 1), a1 + hstep, voffA);
            PG8_WAIT_L(8); PG8_BAR; PG8_WAIT_L(0); PG8_MMA(0, 0, At, B0); PG8_BAR; PG8_SCHED;
            PG8_LDB(B1, 0, 1); PG8_STAGE(PG8_SB(0, 0), b2, voffB);
            PG8_BAR; PG8_WAIT_L(0); PG8_MMA(0, 1, At, B1); PG8_BAR;
            PG8_LDA(At, 0, 1); PG8_STAGE(PG8_SA(0, 0), a2, voffA);
            PG8_BAR; PG8_WAIT_L(0); PG8_MMA(1, 0, At, B0); PG8_BAR; PG8_SCHED;
            PG8_STAGE(PG8_SB(0, 1), b2 + hstep, voffB);
            PG8_WAIT_V(6); PG8_BAR; PG8_MMA(1, 1, At, B1); PG8_BAR;
            PG8_LDB(B0, 1, 0); PG8_SCHED; PG8_LDA(At, 1, 0); PG8_STAGE(PG8_SA(0, 1), a2 + hstep, voffA);
            PG8_WAIT_L(8); PG8_BAR; PG8_WAIT_L(0); PG8_MMA(0, 0, At, B0); PG8_BAR; PG8_SCHED;
            PG8_LDB(B1, 1, 1); PG8_STAGE(PG8_SB(1, 0), b3, voffB);
            PG8_BAR; PG8_WAIT_L(0); PG8_MMA(0, 1, At, B1); PG8_BAR;
            PG8_LDA(At, 1, 1); PG8_STAGE(PG8_SA(1, 0), a3, voffA);
            PG8_BAR; PG8_WAIT_L(0); PG8_MMA(1, 0, At, B0); PG8_BAR; PG8_SCHED;
            PG8_STAGE(PG8_SB(1, 1), b3 + hstep, voffB);
            PG8_WAIT_V(6); PG8_BAR; PG8_MMA(1, 1, At, B1); PG8_BAR;
            }
        }
        if constexpr (ALIGN_EPI) { if (wr == 0) PG8_BAR; }
        if constexpr (!Epi::AFTER_DRAIN) { E(acc, cur, wr, wc, fr, fq); S.done(cur); }
        if (!has_next) break;
#pragma unroll
        for (int a = 0; a < 2; ++a)
#pragma unroll
            for (int b = 0; b < 2; ++b)
#pragma unroll
                for (int m = 0; m < 4; ++m)
#pragma unroll
                    for (int n = 0; n < 2; ++n) acc[a][b][m][n] = (f32x4){0.f, 0.f, 0.f, 0.f};
        cur = nxt; cA = nA; cB = nB; ++ui;
        if constexpr (ALIGN_EPI) { if (wr == 1) PG8_BAR; }
    }
    PG8_WAIT_V(0);
    if constexpr (!ALIGN_EPI) { if (wr == 0) PG8_BAR; }
    PG8_BAR;
    if constexpr (Epi::AFTER_DRAIN) { E.fused(acc, cur, wr, wc, fr, fq, lds, wid, lane); S.done(cur); }
#undef PG8_SA
#undef PG8_SB
#undef PG8_STAGE
#undef PG8_LDA
#undef PG8_LDB
#undef PG8_MMA
#undef PG8_WAIT_V
#undef PG8_WAIT_L
#undef PG8_BAR
#undef PG8_SCHED
}
}

constexpr int NWAVES = 8;
constexpr int D = 1024, NBATCH = 8, SEQ = 2048, NMETA = 16, FF = 4096, NHEAD = 16, HD = 64, DEPTH = 4;
constexpr int MR = NBATCH * SEQ;
constexpr int MT = MR + NMETA;
constexpr float RMS_EPS = 1e-6f;
constexpr float QSCALE = 0.125f * 1.4426950408889634f;

constexpr size_t MiB = 1u << 20;
constexpr size_t WS_W = 0;
constexpr size_t W_CIN0 = 0 * MiB, W_COUT0 = 6 * MiB, W_UP0 = 8 * MiB, W_DN0 = 16 * MiB;
constexpr size_t W_QKV0 = 24 * MiB, W_AOUT0 = 30 * MiB, W_UP1 = 32 * MiB, W_DN1 = 40 * MiB;
constexpr size_t W_CIN1 = 48 * MiB, W_COUT1 = 54 * MiB, W_UP2 = 56 * MiB, W_DN2 = 64 * MiB;
constexpr size_t W_QKV1 = 72 * MiB, W_AOUT1 = 78 * MiB, W_UP3 = 80 * MiB, W_DN3 = 8 * MiB;
constexpr size_t WS_HB = 88 * MiB;
constexpr size_t WS_BIG = 120 * MiB;
constexpr size_t WS_X = 248 * MiB;
constexpr size_t X_CTL = WS_X, CTL_BYTES = 64 * 1024;
constexpr size_t X_SSQ = WS_X + 3 * MiB;
constexpr size_t X_HM = WS_X + 1 * MiB;
constexpr size_t X_HBM = X_HM + 128 * 1024, X_GBM = X_HBM + 128 * 1024, X_UM = X_GBM + 128 * 1024, X_YM = X_UM + 128 * 1024;
constexpr size_t X_QKVM = X_YM + 128 * 1024, X_OM = X_QKVM + 128 * 1024, X_ACTM = X_OM + 128 * 1024, X_SSQP = WS_X + 5 * MiB  , WS_END = WS_X + 7 * MiB + 512 * 1024;

constexpr int RING_BYTES = 131072, LDSCTL_OFF = RING_BYTES, MISC_OFF = LDSCTL_OFF + 320, LDS_BYTES = 147456;

#define GAS __attribute__((address_space(1)))
#define LAS __attribute__((address_space(3)))
typedef unsigned short bf16;
typedef unsigned v4u __attribute__((ext_vector_type(4)));
typedef unsigned v2u __attribute__((ext_vector_type(2)));
typedef float f32x4 __attribute__((ext_vector_type(4)));
typedef float f32x16 __attribute__((ext_vector_type(16)));
typedef short bf16x8 __attribute__((ext_vector_type(8)));
#define LDS_WAIT() asm volatile("s_waitcnt lgkmcnt(0)" ::: "memory")
using pg8::cvt_pk_bf16;
__device__ __forceinline__ float bf2f(unsigned short v) { return __uint_as_float((unsigned)v << 16); }
__device__ __forceinline__ float wave_sum(float v) {
#pragma unroll
    for (int o = 1; o < 64; o <<= 1) v += __shfl_xor(v, o);
    return v;
}
__device__ __forceinline__ int otid(int wv0) { int t; asm volatile("v_mbcnt_lo_u32_b32 %0, -1, 0\n\tv_mbcnt_hi_u32_b32 %0, -1, %0" : "=v"(t)); return t + 64 * wv0; }
template <class T> __device__ __forceinline__ T* opq(T* p) { GAS T* g = (GAS T*)p; asm volatile("" : "+s"(g)); return (T*)g; }
template <class T> __device__ __forceinline__ T* rp(T* real, T* meta, int row, int ld) { return row < MR ? real + (size_t)row * ld : meta + (size_t)(row - MR) * ld; }
__device__ __forceinline__ void store4bf(bf16* dst, f32x4 v) { v2u w; w.x = cvt_pk_bf16(v[0], v[1]); w.y = cvt_pk_bf16(v[2], v[3]); *(v2u*)dst = w; }

#define XB_TMO      128
#define XB_XCNT(j)  (256  + 64 * (j))
#define XB_XSUB(j)  (1280 + 64 * (j))
#define XB_XGEN(j)  (2304 + 64 * (j))
#define XB_TOP      3328
#define XB_TOPGEN   3392
#define XCD_BAR_WORDS 3456
#define XB_SPIN_CAP (1u << 18)

__device__ __forceinline__ unsigned xb_ld(unsigned* p)              { return __hip_atomic_load(p, __ATOMIC_RELAXED, __HIP_MEMORY_SCOPE_AGENT); }
__device__ __forceinline__ unsigned xb_add(unsigned* p, unsigned v) { return __hip_atomic_fetch_add(p, v, __ATOMIC_RELAXED, __HIP_MEMORY_SCOPE_AGENT); }
__device__ __forceinline__ unsigned xb_xcc_id() { return (unsigned)__builtin_amdgcn_s_getreg((3 << 11) | 20) & 0xFu; }
#define XB_SPIN(cond, bar) do { unsigned _sp = 0; while (cond) { __builtin_amdgcn_s_sleep(1); \
    if ((++_sp & 255u) == 0u) { if (xb_ld(&(bar)[XB_TMO])) break; if (_sp > XB_SPIN_CAP) { atomicAdd(&(bar)[XB_TMO], 1u); break; } } } } while (0)

struct XcdBarrier {
    unsigned* bar; unsigned x;
    volatile LAS unsigned* st;
};

__device__ __forceinline__ XcdBarrier xcd_barrier_post(unsigned* bar, volatile LAS unsigned* st) {
    XcdBarrier b; b.bar = bar; b.x = xb_xcc_id(); b.st = st;
    if (threadIdx.x == 0) (void)xb_add(&bar[XB_XCNT(b.x)], 1u);
    return b;
}
__device__ __forceinline__ void xcd_barrier_complete(unsigned* bar, unsigned x, unsigned& nloc, unsigned& nx) {
    const unsigned G = gridDim.x * gridDim.y * gridDim.z;
    unsigned sum, cnt, mine, sp = 0u;
    for (;;) {
        sum = 0u; cnt = 0u; mine = 0u;
#pragma unroll
        for (unsigned j = 0; j < 16; ++j) { const unsigned c = xb_ld(&bar[XB_XCNT(j)]); sum += c; cnt += (c > 0u) ? 1u : 0u; mine = (j == x) ? c : mine; }
        if (sum == G) break;
        __builtin_amdgcn_s_sleep(1);
        if ((++sp & 255u) == 0u) { if (xb_ld(&bar[XB_TMO])) break; if (sp > XB_SPIN_CAP) { atomicAdd(&bar[XB_TMO], 1u); break; } }
    }
    nloc = mine > 0u ? mine : 1u; nx = cnt > 0u ? cnt : 1u;
}

__device__ __forceinline__ void xcd_barrier(const XcdBarrier& b) {
    asm volatile("s_waitcnt vmcnt(0)" ::: "memory");
    __syncthreads();
    if (threadIdx.x == 0) {
        unsigned* bar = b.bar;
        __builtin_amdgcn_s_waitcnt(0);
        unsigned nloc = b.st[0], nx = b.st[1];
        if (nloc == 0u) { xcd_barrier_complete(bar, b.x, nloc, nx); b.st[0] = nloc; b.st[1] = nx; }
        const unsigned old = xb_add(&bar[XB_XSUB(b.x)], 1u);
        const unsigned gen = old / nloc;
        if (old + 1u == (gen + 1u) * nloc) {
            __builtin_amdgcn_fence(__ATOMIC_RELEASE, "agent");
            asm volatile("s_waitcnt vmcnt(0)" ::: "memory");
            const unsigned og = xb_add(&bar[XB_TOP], 1u);
            const unsigned tg = og / nx;
            if (og + 1u == (tg + 1u) * nx) xb_add(&bar[XB_TOPGEN], 1u);
            asm volatile("buffer_inv sc1" ::: "memory");
            if (og + 1u != (tg + 1u) * nx) XB_SPIN(xb_ld(&bar[XB_TOPGEN]) == tg, bar);
            asm volatile("" ::: "memory");
            xb_add(&bar[XB_XGEN(b.x)], 1u);
            asm volatile("s_waitcnt vmcnt(0)" ::: "memory");
        } else {
            asm volatile("buffer_inv sc1" ::: "memory");
            XB_SPIN(xb_ld(&bar[XB_XGEN(b.x)]) == gen, bar);
            asm volatile("" ::: "memory");
            asm volatile("s_waitcnt vmcnt(0)" ::: "memory");
        }
    }
    __syncthreads();
}

template <class Work> __device__ __forceinline__ void xcd_barrier_w(const XcdBarrier& b, const int tid, const Work& work) {
    asm volatile("s_waitcnt vmcnt(0)" ::: "memory");
    __syncthreads();
    if (tid == 0) {
        unsigned* bar = b.bar;
        __builtin_amdgcn_s_waitcnt(0);
        unsigned nloc = b.st[0], nx = b.st[1];
        if (nloc == 0u) { xcd_barrier_complete(bar, b.x, nloc, nx); b.st[0] = nloc; b.st[1] = nx; }
        const unsigned old = xb_add(&bar[XB_XSUB(b.x)], 1u);
        const unsigned gen = old / nloc;
        if (old + 1u == (gen + 1u) * nloc) {
            __builtin_amdgcn_fence(__ATOMIC_RELEASE, "agent");
            asm volatile("s_waitcnt vmcnt(0)" ::: "memory");
            const unsigned og = xb_add(&bar[XB_TOP], 1u);
            const unsigned tg = og / nx;
            if (og + 1u == (tg + 1u) * nx) xb_add(&bar[XB_TOPGEN], 1u);
            asm volatile("buffer_inv sc1" ::: "memory");
            if (og + 1u != (tg + 1u) * nx) XB_SPIN(xb_ld(&bar[XB_TOPGEN]) == tg, bar);
            asm volatile("" ::: "memory");
            xb_add(&bar[XB_XGEN(b.x)], 1u);
            asm volatile("s_waitcnt vmcnt(0)" ::: "memory");
        } else {
            asm volatile("buffer_inv sc1" ::: "memory");
            XB_SPIN(xb_ld(&bar[XB_XGEN(b.x)]) == gen, bar);
            asm volatile("" ::: "memory");
            asm volatile("s_waitcnt vmcnt(0)" ::: "memory");
        }
    }
    else if (tid >= 64) work();
    asm volatile("s_waitcnt lgkmcnt(0)" ::: "memory"); __builtin_amdgcn_s_barrier(); asm volatile("" ::: "memory");
}


typedef unsigned long long ssq_t;
constexpr float SSQ_FIX = 1048576.0f;
__device__ __forceinline__ ssq_t ssq_enc(float ss) { return (ssq_t)(ss * SSQ_FIX + 0.5f); }
__device__ __forceinline__ float ssq_rs(ssq_t v) { return rsqrtf((float)v * (1.0f / (SSQ_FIX * D)) + RMS_EPS); }
enum { K_CONVIN = 0, K_QKV = 1, K_UP = 2, K_RESID = 3 };
__device__ __forceinline__ f32x4 relu2(f32x4 t) { t[0] = fmaxf(t[0], 0.f); t[1] = fmaxf(t[1], 0.f); t[2] = fmaxf(t[2], 0.f); t[3] = fmaxf(t[3], 0.f); return t * t; }
__device__ __forceinline__ v4u pack8(f32x4 a, f32x4 b) { v4u w; w.x = cvt_pk_bf16(a[0], a[1]); w.y = cvt_pk_bf16(a[2], a[3]); w.z = cvt_pk_bf16(b[0], b[1]); w.w = cvt_pk_bf16(b[2], b[3]); return w; }
constexpr int RSTAB_OFF = RING_BYTES + 1024;
struct EpiArgs { const ssq_t* ssq; bf16* o0; bf16* o1; const float* base; float* out; ssq_t* ssq_out; float scale; const float* ssqp; float* ssqp_out; };
__device__ __forceinline__ float ssqp_rs(const float* p) { const f32x4 v = *(const f32x4*)p; return rsqrtf(((v[0] + v[1]) + (v[2] + v[3])) * (1.0f / D) + RMS_EPS); }
constexpr int SSPART_OFF = RING_BYTES + 2048;
template <int KIND> struct Epi {
    static constexpr bool PERM = true, AFTER_DRAIN = false; EpiArgs a; const LAS float* rstab; int pm0; LAS float* sspart;
    __device__ __forceinline__ void operator()(const f32x4 (&acc)[2][2][4][2], const pg8::Unit& u, int wr, int wc, int fr, int fq) const {
        const int row0 = u.pm * 256 + wr * 64 + fr;
        if constexpr (KIND == K_RESID) {
            bf16* ob = a.o0 + (size_t)row0 * D + u.pn * 256 + wc * 32 + 8 * fq;
#pragma unroll
            for (int ai = 0; ai < 2; ++ai) {
                v4u bw[4][2];
#pragma unroll
                for (int m = 0; m < 4; ++m)
#pragma unroll
                    for (int bj = 0; bj < 2; ++bj) bw[m][bj] = *(const v4u*)(ob + (size_t)(ai * 128 + m * 16) * D + bj * 128);
#pragma unroll
                for (int m = 0; m < 4; ++m) { float ss = 0.f;
#pragma unroll
                    for (int bj = 0; bj < 2; ++bj) { const v4u w = bw[m][bj];
                        const f32x4 b0 = {__uint_as_float(w.x << 16), __uint_as_float(w.x & 0xffff0000u), __uint_as_float(w.y << 16), __uint_as_float(w.y & 0xffff0000u)};
                        const f32x4 b1 = {__uint_as_float(w.z << 16), __uint_as_float(w.z & 0xffff0000u), __uint_as_float(w.w << 16), __uint_as_float(w.w & 0xffff0000u)};
                        const f32x4 o0 = b0 + acc[ai][bj][m][0] * a.scale, o1 = b1 + acc[ai][bj][m][1] * a.scale;
                        *(v4u*)(ob + (size_t)(ai * 128 + m * 16) * D + bj * 128) = pack8(o0, o1);
                        ss += ((o0[0] * o0[0] + o0[1] * o0[1]) + (o0[2] * o0[2] + o0[3] * o0[3])) + ((o1[0] * o1[0] + o1[1] * o1[1]) + (o1[2] * o1[2] + o1[3] * o1[3])); }
                    ss += __shfl_xor(ss, 16); ss += __shfl_xor(ss, 32); if (fq == 0) sspart[(ai * 128 + wr * 64 + m * 16 + fr) * 4 + wc] = ss; }
            }
            asm volatile("s_waitcnt lgkmcnt(0)" ::: "memory"); __builtin_amdgcn_s_barrier(); asm volatile("" ::: "memory");
            { const int t_ = (wr * 4 + wc) * 64 + fq * 16 + fr; if (t_ < 256) { const f32x4 pp = *(const LAS f32x4*)(sspart + t_ * 4); a.ssqp_out[(size_t)(u.pm * 256 + t_) * 4 + u.pn] = (pp[0] + pp[1]) + (pp[2] + pp[3]); } }
        } else {
            constexpr int LD = KIND == K_CONVIN ? D : KIND == K_QKV ? 3 * D : FF;
            const bool pairt = KIND == K_CONVIN && u.pn >= 4;
            bf16* ob = pairt ? a.o1 + (size_t)row0 * LD + 128 * (u.pn - 4) + wc * 32 + 8 * fq : a.o0 + (size_t)row0 * LD + u.pn * 256 + wc * 32 + 8 * fq;
            const float qs = (KIND == K_QKV && u.pn < 4) ? QSCALE : 1.0f;
#pragma unroll
            for (int ai = 0; ai < 2; ++ai)
#pragma unroll
                for (int m = 0; m < 4; ++m) { const float rs = (u.pm == pm0 ? rstab[wr * 64 + fr + ai * 128 + m * 16] : ssqp_rs(a.ssqp + (size_t)(row0 + ai * 128 + m * 16) * 4)) * qs; bf16* rowp = ob + (size_t)(ai * 128 + m * 16) * LD;
                    if (pairt) { *(v4u*)rowp = pack8((acc[ai][0][m][0] * rs) * (acc[ai][1][m][0] * rs), (acc[ai][0][m][1] * rs) * (acc[ai][1][m][1] * rs)); }
                    else {
#pragma unroll
                        for (int bj = 0; bj < 2; ++bj) { f32x4 v0 = acc[ai][bj][m][0] * rs, v1 = acc[ai][bj][m][1] * rs; if (KIND == K_UP) { v0 = relu2(v0); v1 = relu2(v1); } *(v4u*)(rowp + bj * 128) = pack8(v0, v1); } } }
        }
    }
};
template <int KIND> __device__ __forceinline__ int mini_item_col(int item) { if (KIND == K_CONVIN && item >= 64) { const int k = item - 64; return 1024 + 256 * (k >> 3) + 16 * (k & 7); } return 16 * item; }
template <int KIND> __device__ __forceinline__ void mini_epi(const EpiArgs& a, int n0, int fr, int fq, f32x4 v0, f32x4 v1, const float rs, const v2u w  ) {
    const int col = n0 + 4 * fq;
    if constexpr (KIND == K_RESID) {
        const size_t o2 = (size_t)fr * D + col;
        const f32x4 bb = {__uint_as_float(w.x << 16), __uint_as_float(w.x & 0xffff0000u), __uint_as_float(w.y << 16), __uint_as_float(w.y & 0xffff0000u)};
        const f32x4 o = bb + v0 * a.scale; store4bf(a.o0 + o2, o); float ss = (o[0] * o[0] + o[1] * o[1]) + (o[2] * o[2] + o[3] * o[3]);
        ss += __shfl_xor(ss, 16); ss += __shfl_xor(ss, 32); if (fq == 0) atomicAdd(a.ssq_out + fr, ssq_enc(ss));
    } else {
        if (KIND == K_CONVIN) { if (n0 < 1024) store4bf(a.o0 + (size_t)fr * D + col, v0 * rs); else { const int k = col - 1024; store4bf(a.o1 + (size_t)fr * D + 128 * (k >> 8) + (k & 127), (v0 * rs) * (v1 * rs)); } }
        else if (KIND == K_QKV) store4bf(a.o0 + (size_t)fr * (3 * D) + col, v0 * (n0 < 1024 ? rs * QSCALE : rs));
        else store4bf(a.o0 + (size_t)fr * FF + col, relu2(v0 * rs));
    }
}

template <int KIND, int K> __device__ __forceinline__ void mini_gemm(LAS unsigned char* lds, const bf16* Am, const bf16* Bt, int nitems, const EpiArgs& am, int vcu, int G, const int wv0) {
    const int tid = otid(wv0), lane = tid & 63, wid = __builtin_amdgcn_readfirstlane(tid >> 6), fr = lane & 15, fq = lane >> 4;
    LAS f32x4* red = (LAS f32x4*)lds;
    for (int item = vcu; item < nitems; item += G) {
        const int n0 = mini_item_col<KIND>(item); const bool pair = KIND == K_CONVIN && n0 >= 1024;
        constexpr int kw = K >> 3; const int k0 = wid * kw;
        float rs_pre = 1.0f; v2u base_pre = {0u, 0u};
        if (KIND == K_RESID) { if (wid == 0) base_pre = *(const v2u*)(am.o0 + (size_t)fr * D + n0 + 4 * fq); } else { if (wid == 0) rs_pre = ssq_rs(am.ssq[fr]); }
        f32x4 a0 = {0.f, 0.f, 0.f, 0.f}, a1 = {0.f, 0.f, 0.f, 0.f};
        const bf16* ap = Am + (size_t)fr * K + k0 + 8 * fq; const bf16* bp = Bt + (size_t)(n0 + fr) * K + k0 + 8 * fq; const bf16* bp2 = bp + (size_t)128 * K;
#pragma unroll
        for (int kk = 0; kk < kw; kk += 32) {
            const bf16x8 av = *(const bf16x8*)(ap + kk), bv = *(const bf16x8*)(bp + kk);
            a0 = __builtin_amdgcn_mfma_f32_16x16x32_bf16(bv, av, a0, 0, 0, 0);
            if (pair) { const bf16x8 b2 = *(const bf16x8*)(bp2 + kk); a1 = __builtin_amdgcn_mfma_f32_16x16x32_bf16(b2, av, a1, 0, 0, 0); }
        }
        red[(wid * 2 + 0) * 64 + lane] = a0; red[(wid * 2 + 1) * 64 + lane] = a1;
        asm volatile("s_waitcnt lgkmcnt(0)" ::: "memory"); __builtin_amdgcn_s_barrier(); asm volatile("" ::: "memory");
        if (wid == 0) {
            f32x4 v0 = red[lane], v1 = red[64 + lane];
#pragma unroll
            for (int w = 1; w < 8; ++w) { v0 += red[(w * 2) * 64 + lane]; v1 += red[(w * 2 + 1) * 64 + lane]; }
            mini_epi<KIND>(am, n0, fr, fq, v0, v1, rs_pre, base_pre);
        }
        asm volatile("s_waitcnt lgkmcnt(0)" ::: "memory"); __builtin_amdgcn_s_barrier(); asm volatile("" ::: "memory");
    }
}

__device__ __forceinline__ unsigned f2bf(float f) { unsigned u = __builtin_bit_cast(unsigned, f); return (u + 0x7fffu + ((u >> 16) & 1u)) >> 16; }
__device__ __forceinline__ unsigned pk2(float lo, float hi) { return f2bf(lo) | (f2bf(hi) << 16); }
__device__ __forceinline__ void transpose_item(const float* W, const float* g, int K, int N, bf16* WT, int perm, LAS float* scr, int item, int lane) {
    const int nblk = N / 32, kb = item / nblk, nb = item % nblk, k0 = 64 * kb, n0 = 32 * nb;
    float wv[32];
#pragma unroll
    for (int i = 0; i < 32; ++i) wv[i] = __builtin_nontemporal_load(W + (size_t)(k0 + 2 * i + (lane >> 5)) * N + n0 + (lane & 31));
#pragma unroll
    for (int i = 0; i < 32; ++i) { const int kk = 2 * i + (lane >> 5); const float gv = g ? g[k0 + kk] : 1.0f; scr[kk * 33 + (lane & 31)] = wv[i] * gv; }
    LDS_WAIT(); asm volatile("" ::: "memory");
    int n0p = n0;
    if (perm && n0 >= 1024) { int j = n0 - 1024; const int isv = j >= 1024 ? 1 : 0; j -= isv * 1024; n0p = 1024 + 256 * (j >> 7) + 128 * isv + (j & 127); }
    const int c = lane & 7;
#pragma unroll
    for (int j = 0; j < 4; ++j) { const int n = (lane >> 3) + 8 * j; const LAS float* s = scr + (8 * c) * 33 + n;
        v4u o; o.x = pk2(s[0 * 33], s[1 * 33]); o.y = pk2(s[2 * 33], s[3 * 33]); o.z = pk2(s[4 * 33], s[5 * 33]); o.w = pk2(s[6 * 33], s[7 * 33]);
        *(v4u*)(WT + (size_t)(n0p + n) * K + k0 + 8 * c) = o; }
    LDS_WAIT(); asm volatile("" ::: "memory");
}
struct MatDesc { const float* W; const float* g; int K, N; bf16* WT; int perm; };
struct Args { const float* in[13]; float* out; unsigned char* ws; int pad0, pad1; };
__device__ __forceinline__ MatDesc mat_desc(const Args& a, int idx) {
    bf16* wb = (bf16*)(a.ws + WS_W); MatDesc m;
    const float *conv_norm = a.in[2], *conv_w_in = a.in[3], *conv_w_out = a.in[5], *attn_norm = a.in[6], *attn_w_qkv = a.in[7], *attn_w_out = a.in[8], *mlp_norm = a.in[9], *w1 = a.in[10], *w2 = a.in[11];
    if (idx < 2)       { m.W = conv_w_in + (size_t)idx * D * 3 * D; m.g = conv_norm + idx * D; m.K = D; m.N = 3 * D; m.WT = (bf16*)((unsigned char*)wb + (idx ? W_CIN1 : W_CIN0)); m.perm = 1; }
    else if (idx < 4)  { const int j = idx - 2; m.W = conv_w_out + (size_t)j * D * D; m.g = nullptr; m.K = D; m.N = D; m.WT = (bf16*)((unsigned char*)wb + (j ? W_COUT1 : W_COUT0)); m.perm = 0; }
    else if (idx < 6)  { const int j = idx - 4; m.W = attn_w_qkv + (size_t)j * D * 3 * D; m.g = attn_norm + j * D; m.K = D; m.N = 3 * D; m.WT = (bf16*)((unsigned char*)wb + (j ? W_QKV1 : W_QKV0)); m.perm = 0; }
    else if (idx < 8)  { const int j = idx - 6; m.W = attn_w_out + (size_t)j * D * D; m.g = nullptr; m.K = D; m.N = D; m.WT = (bf16*)((unsigned char*)wb + (j ? W_AOUT1 : W_AOUT0)); m.perm = 0; }
    else if (idx < 12) { const int j = idx - 8; m.W = w1 + (size_t)j * D * FF; m.g = mlp_norm + j * D; m.K = D; m.N = FF; m.WT = (bf16*)((unsigned char*)wb + (j == 0 ? W_UP0 : j == 1 ? W_UP1 : j == 2 ? W_UP2 : W_UP3)); m.perm = 0; }
    else               { const int j = idx - 12; m.W = w2 + (size_t)j * FF * D; m.g = nullptr; m.K = FF; m.N = D; m.WT = (bf16*)((unsigned char*)wb + (j == 0 ? W_DN0 : j == 1 ? W_DN1 : j == 2 ? W_DN2 : W_DN3)); m.perm = 0; }
    return m;
}
__device__ __forceinline__ void convert_mats(const Args& a, int idx_lo, int idx_hi, LAS unsigned char* lds, int gw, int NGW, int wave, int lane) {
    LAS float* scr = (LAS float*)(lds + wave * 16384);
    for (int idx = idx_lo; idx < idx_hi; ++idx) {
        const MatDesc m = mat_desc(a, idx); const int nitems = (m.K / 64) * (m.N / 32);
        for (int it = gw; it < nitems; it += NGW) transpose_item(m.W, m.g, m.K, m.N, m.WT, m.perm, scr, it, lane);
    }
}

constexpr int CONV_ITEMS_L0 = 4608, CONV_ITEMS_L = 6144, CONV_ITEMS = CONV_ITEMS_L0 + 3 * CONV_ITEMS_L, CONV_CAP_MIN = 1792;
__device__ __forceinline__ void convert_quantum(const Args& a, int s, LAS unsigned char* lds, int vcu, int G, int wave, int lane) {
    LAS float* scr = (LAS float*)(lds + wave * 16384);
    const int cap = G * (NWAVES - 1);
    for (int gi = s * cap + vcu * (NWAVES - 1) + (wave - 1); gi < CONV_ITEMS && gi < (s + 1) * cap; gi += cap) {
        int idx, li;
        if (gi < CONV_ITEMS_L0) { if (gi < 512) { idx = 2; li = gi; } else if (gi < 2560) { idx = 8; li = gi - 512; } else { idx = 12; li = gi - 2560; } }
        else { const int g2 = gi - CONV_ITEMS_L0, tl = 1 + g2 / CONV_ITEMS_L, r = g2 % CONV_ITEMS_L;
            if (r < 1536) { idx = (tl & 1) ? 4 + (tl >> 1) : (tl >> 1); li = r; }
            else if (r < 2048) { idx = ((tl & 1) ? 6 : 2) + (tl >> 1); li = r - 1536; }
            else if (r < 4096) { idx = 8 + tl; li = r - 2048; }
            else { idx = 12 + tl; li = r - 4096; } }
        const MatDesc m = mat_desc(a, idx); transpose_item(m.W, m.g, m.K, m.N, m.WT, m.perm, scr, li, lane);
    }
}

__device__ __forceinline__ int crow(int r, int hi) { return (r & 3) + 8 * (r >> 2) + 4 * hi; }
constexpr int KS_STRIDE = 144, VT_STRIDE = 136, KS_BYTES = 64 * KS_STRIDE, VT_BYTES = 64 * VT_STRIDE;
constexpr int AK_STRIDE = 144, AV_STRIDE = 192, AW_V = 32 * AK_STRIDE, AW_BYTES = AW_V + 32 * AV_STRIDE, AW_STG = 0;
constexpr float TAIL_ZERO = 5.421010862427522e-20f;
typedef short v4i16_t __attribute__((ext_vector_type(4)));
__device__ __forceinline__ v2u vtr(const LAS unsigned char* p) { return __builtin_bit_cast(v2u, __builtin_amdgcn_ds_read_tr16_b64_v4i16((LAS v4i16_t*)p)); }
__device__ __forceinline__ const bf16* pos_row(const bf16* qkv_b, const bf16* qkvm, int p) { p = p < 0 ? 0 : p; return p >= NMETA ? qkv_b + (size_t)(p - NMETA) * (3 * D) : qkvm + (size_t)p * (3 * D); }
__device__ __forceinline__ void attn_wave(LAS unsigned char* lw, const bf16* qkv, const bf16* qkvm, bf16* O, int b, int h, int tq0, int lane) {
    const int r = lane & 31, hi = lane >> 5, tq = tq0 + r, pq = tq + NMETA;
    const bf16* qkv_b = qkv + (size_t)(b * SEQ) * (3 * D);
    const bf16* qp = qkv_b + (size_t)tq * (3 * D) + h * HD + hi * 8;
    bf16x8 qf[4];
#pragma unroll
    for (int d0 = 0; d0 < 4; ++d0) qf[d0] = *(const bf16x8*)(qp + 16 * d0);
    f32x16 o0, o1;
#pragma unroll
    for (int i = 0; i < 16; ++i) { o0[i] = 0.f; o1[i] = 0.f; }
    float R = 1.0f;
    const int koff = D + h * HD + (lane & 7) * 8, vrow = lane >> 3;
    v4u kr[2][4], vr[2][4];
    int P0 = tq0 + NMETA + 32 - 64;
    const unsigned lane_off = (unsigned)(vrow * (3 * D) + (lane & 7) * 8) * 2u;
#define ATT_FETCH(PP, kb) do { const int pb_ = (PP) + 32 * (kb); \
        if (pb_ >= NMETA) { const char* sb_ = (const char*)(qkv_b + (size_t)(pb_ - NMETA) * (3 * D) + D + h * HD);     \
            _Pragma("unroll") for (int i = 0; i < 4; ++i) { const char* rp_ = sb_ + (size_t)i * (8 * 3 * D * 2) + lane_off; kr[kb][i] = *(const v4u*)rp_; vr[kb][i] = *(const v4u*)(rp_ + 2 * D); } } \
        else { _Pragma("unroll") for (int i = 0; i < 4; ++i) { const bf16* rp_ = pos_row(qkv_b, qkvm, pb_ + vrow + 8 * i) + koff; kr[kb][i] = *(const v4u*)rp_; vr[kb][i] = *(const v4u*)(rp_ + D); } } } while (0)
    ATT_FETCH(P0, 1); ATT_FETCH(P0, 0);
    const LAS unsigned char* krd = lw + r * AK_STRIDE + 16 * hi;
    const LAS unsigned char* vrd = lw + AW_V + (4 * hi + ((lane & 15) >> 2)) * AV_STRIDE + (16 * ((lane >> 4) & 1) + 4 * (lane & 3)) * 2;
    LAS unsigned char* kwr = lw + vrow * AK_STRIDE + (lane & 7) * 16; LAS unsigned char* vwr = lw + AW_V + vrow * AV_STRIDE + (lane & 7) * 16;
    for (; P0 > -64; P0 -= 64) {
        const bool need_mask = (P0 + 64 > tq0 + NMETA) || (P0 < 0);
        const int lim_hi = pq - P0, lim_lo = -P0;
        float run = R; bool half_exit = false;
#pragma unroll
        for (int kb = 1; kb >= 0; --kb) {
#pragma unroll
            for (int i = 0; i < 4; ++i) { *(LAS v4u*)(kwr + 8 * i * AK_STRIDE) = kr[kb][i]; *(LAS v4u*)(vwr + 8 * i * AV_STRIDE) = vr[kb][i]; }
            if (P0 > 0) ATT_FETCH(P0 - 64, kb);
            f32x16 p;
#pragma unroll
            for (int i = 0; i < 16; ++i) p[i] = 0.f;
            bf16x8 kfr[4];
#pragma unroll
            for (int d0 = 0; d0 < 4; ++d0) kfr[d0] = *(const LAS bf16x8*)(krd + 32 * d0);
            __builtin_amdgcn_s_setprio(1);
#pragma unroll
            for (int d0 = 0; d0 < 4; ++d0) p = __builtin_amdgcn_mfma_f32_32x32x16_bf16(kfr[d0], qf[d0], p, 0, 0, 0);
            __builtin_amdgcn_s_setprio(0);
            float bt[16], om[16];
#pragma unroll
            for (int i = 0; i < 16; ++i) {
                const float zc = __builtin_amdgcn_fmed3f(p[i], -INFINITY, 126.0f);
                const float u = __builtin_amdgcn_exp2f(zc); om[i] = __builtin_amdgcn_rcpf(1.0f + u); bt[i] = u * om[i];
            }
            if (need_mask) {
#pragma unroll
                for (int i = 0; i < 16; ++i) { const int ki = 32 * kb + crow(i, hi); if (ki >= lim_hi || ki < lim_lo) { bt[i] = 0.f; om[i] = 1.f; } }
            }
            float own[4], oth[4], T[4];
#pragma unroll
            for (int g = 0; g < 4; ++g) { float sa = om[4 * g] * om[4 * g + 1]; asm("" : "+v"(sa)); float sb = om[4 * g + 2] * om[4 * g + 3]; asm("" : "+v"(sb)); own[g] = sa * sb; asm("" : "+v"(own[g]));
                const auto sw = __builtin_amdgcn_permlane32_swap(__float_as_uint(own[g]), __float_as_uint(own[g]), false, false);
                own[g] = __uint_as_float(sw[0]); oth[g] = __uint_as_float(sw[1]); }
#pragma unroll
            for (int g = 3; g >= 0; --g) { const float A = own[g], B = oth[g];
                const float tB = run; run *= B; const float tA = run; run *= A; T[g] = hi ? tB : tA; }
            unsigned pw[8];
#pragma unroll
            for (int g = 0; g < 4; ++g) { float t = T[g]; float w[4];
#pragma unroll
                for (int i = 3; i >= 0; --i) { w[i] = bt[4 * g + i] * t; t *= om[4 * g + i]; }
                pw[2 * g] = cvt_pk_bf16(w[0], w[1]); pw[2 * g + 1] = cvt_pk_bf16(w[2], w[3]); }
            bf16x8 vfr[2][2];
#pragma unroll
            for (int s = 0; s < 2; ++s)
#pragma unroll
                for (int dh = 0; dh < 2; ++dh) { const v2u lo = vtr(vrd + (16 * s) * AV_STRIDE + 64 * dh), hi8 = vtr(vrd + (16 * s + 8) * AV_STRIDE + 64 * dh);
                    const v4u vf4 = {lo.x, lo.y, hi8.x, hi8.y}; vfr[s][dh] = __builtin_bit_cast(bf16x8, vf4); }
            __builtin_amdgcn_s_setprio(1);
#pragma unroll
            for (int s = 0; s < 2; ++s) {
                const v4u pa4 = {pw[4 * s], pw[4 * s + 1], pw[4 * s + 2], pw[4 * s + 3]}; const bf16x8 pa = __builtin_bit_cast(bf16x8, pa4);
                o0 = __builtin_amdgcn_mfma_f32_32x32x16_bf16(pa, vfr[s][0], o0, 0, 0, 0); o1 = __builtin_amdgcn_mfma_f32_32x32x16_bf16(pa, vfr[s][1], o1, 0, 0, 0);
            }
            __builtin_amdgcn_s_setprio(0);
            if (kb == 1 && __all(run < TAIL_ZERO)) { half_exit = true; break; }
        }
        R = run;
        if (half_exit || __all(R < TAIL_ZERO)) break;
    }
#undef ATT_FETCH
    {   LAS bf16* stg = (LAS bf16*)(lw + AW_STG);
#pragma unroll
        for (int i = 0; i < 16; ++i) { const int q = crow(i, hi); stg[q * 64 + r] = (bf16)(cvt_pk_bf16(o0[i], 0.f) & 0xffffu); stg[q * 64 + 32 + r] = (bf16)(cvt_pk_bf16(o1[i], 0.f) & 0xffffu); }
        LDS_WAIT();
        bf16* ob = O + (size_t)(b * SEQ + tq0) * D + h * HD;
#pragma unroll
        for (int i = 0; i < 4; ++i) { const int row = i * 8 + (lane >> 3), c8 = lane & 7; const v4u v = *(const LAS v4u*)(stg + row * 64 + c8 * 8); *(v4u*)(ob + (size_t)row * D + c8 * 8) = v; }
        LDS_WAIT();
    }
}
__device__ __forceinline__ void attn_meta(LAS unsigned char* lw, const bf16* qkvm, bf16* Om, int h, int lane) {
    asm volatile("" : "+v"(lane));
    const int t = lane & 15, dg = lane >> 4;
    {   const bf16* src = qkvm + (size_t)(lane >> 3) * (3 * D) + D + h * HD + (lane & 7) * 8;
        const v4u k0 = *(const v4u*)src, k1 = *(const v4u*)(src + (size_t)8 * (3 * D)), v0 = *(const v4u*)(src + D), v1 = *(const v4u*)(src + (size_t)8 * (3 * D) + D);
        LAS v4u* dst = (LAS v4u*)(lw + (lane >> 3) * 128 + (lane & 7) * 16);
        dst[0] = k0; dst[64] = k1; dst[128] = v0; dst[192] = v1; }
    bf16x8 q[8];
#pragma unroll
    for (int c = 0; c < 8; ++c) q[c] = *(const bf16x8*)(qkvm + (size_t)t * (3 * D) + h * HD + 8 * c);
    float acc[16];
#pragma unroll
    for (int i = 0; i < 16; ++i) acc[i] = 0.f;
    float R = 0.f;
    LDS_WAIT();
    for (int s = NMETA - 2; s >= 0; --s) {
        const LAS unsigned char* kp = lw + 128 * s; float z = 0.f;
#pragma unroll
        for (int c = 0; c < 8; ++c) { const bf16x8 kc = *(const LAS bf16x8*)(kp + 16 * c);
#pragma unroll
            for (int e = 0; e < 8; ++e) z += bf2f((unsigned short)q[c][e]) * bf2f((unsigned short)kc[e]); }
        const float e = __builtin_amdgcn_exp2f(-fabsf(z)), l = __builtin_amdgcn_logf(1.0f + e), lbv = fminf(z, 0.f) - l, lmv = lbv - z;
        const bool valid = s < t; const float w = valid ? __builtin_amdgcn_exp2f(lbv + R) : 0.f; if (valid) R += lmv;
        const LAS unsigned char* vp = lw + 2048 + 128 * s + dg * 32;
        const bf16x8 va = *(const LAS bf16x8*)vp, vb = *(const LAS bf16x8*)(vp + 16);
#pragma unroll
        for (int i = 0; i < 8; ++i) { acc[i] += w * bf2f((unsigned short)va[i]); acc[8 + i] += w * bf2f((unsigned short)vb[i]); }
    }
    bf16* op = Om + (size_t)t * D + h * HD + dg * 16;
    v4u w0, w1; w0.x = cvt_pk_bf16(acc[0], acc[1]); w0.y = cvt_pk_bf16(acc[2], acc[3]); w0.z = cvt_pk_bf16(acc[4], acc[5]); w0.w = cvt_pk_bf16(acc[6], acc[7]);
    w1.x = cvt_pk_bf16(acc[8], acc[9]); w1.y = cvt_pk_bf16(acc[10], acc[11]); w1.z = cvt_pk_bf16(acc[12], acc[13]); w1.w = cvt_pk_bf16(acc[14], acc[15]);
    *(v4u*)op = w0; *(v4u*)(op + 8) = w1;
    LDS_WAIT();
}

template <int KIND> __device__ __forceinline__ void do_gemm(LAS unsigned char* lds, const bf16* A, const bf16* Am, const bf16* Bt, int N, int K, int nmini, const EpiArgs& ar, const EpiArgs& am, int vcu, int G, const int wv0) {
    pg8::Gemm g{A, Bt, MR, N, K}; pg8::StaticOrder S; S.init(MR, N, G, (int)blockIdx.x);
    pg8::Unit u0{0, 0}; (void)S.next(0, u0);
    Epi<KIND> E{ar, (const LAS float*)(lds + RSTAB_OFF), u0.pm, (LAS float*)(lds + SSPART_OFF)};
    auto pre = [&]() { if (KIND != K_RESID) { const int t_ = otid(wv0); if (t_ < 256) ((LAS float*)(lds + RSTAB_OFF))[t_] = ssqp_rs(ar.ssqp + (size_t)(u0.pm * 256 + t_) * 4); }
        if (K == D) mini_gemm<KIND, D>(lds + 49152, Am, Bt, nmini, am, vcu, G, wv0); else mini_gemm<KIND, FF>(lds + 49152, Am, Bt, nmini, am, vcu, G, wv0); };
    pg8::gemm_phase<Epi<KIND>, pg8::StaticOrder, true, true>(lds, g, S, E, wv0, pre);
}


#ifndef REP_BAR
#define REP_BAR 1
#endif
#ifndef REP_P0
#define REP_P0 1
#endif
#ifndef REP_IN
#define REP_IN 1
#endif
#ifndef REP_UP
#define REP_UP 1
#endif
#ifndef REP_ATT
#define REP_ATT 1
#endif
#ifndef REP_RES
#define REP_RES 1
#endif
#ifndef REP_CONV
#define REP_CONV 1
#endif
__global__ void __launch_bounds__(NWAVES * 64, 2) fwd_megakernel(Args args) {
    extern __shared__ __attribute__((aligned(16))) unsigned char lds_raw[];
    LAS unsigned char* lds = (LAS unsigned char*)lds_raw;
    const int wv0 = __builtin_amdgcn_readfirstlane(threadIdx.x >> 6);
    const int G = gridDim.x, bx = blockIdx.x, vcu = (G % 8 == 0) ? (bx % 8) * (G / 8) + bx / 8 : bx;
    const int NGW = G * NWAVES;
#define WSP(T, off) ((T*)(ws + (off)))
#define TIDS() const int tid = otid(wv0), lane = tid & 63, wave = __builtin_amdgcn_readfirstlane(tid >> 6), gw = vcu * NWAVES + wave; (void)lane; (void)gw
#define NROWI() ((G == 256) ? 9 : (MT + NGW - 1) / NGW)
#define ROWI(i) ((G == 256) ? ((i) < 8 ? (vcu >> 5) * SEQ + ((vcu & 31) * NWAVES + wave) + 256 * (i) : ((vcu < 2) ? MR + vcu * NWAVES + wave : MT)) : gw + (i) * NGW)
    {   TIDS();
        for (int u = tid; u < (LDS_BYTES - LDSCTL_OFF) / 4; u += NWAVES * 64) ((LAS unsigned*)(lds + LDSCTL_OFF))[u] = 0u;
        __syncthreads();
        (void)xcd_barrier_post((unsigned*)(args.ws + X_CTL) + 1024, (volatile LAS unsigned*)(lds + MISC_OFF) + 8);
    }
#define GRID_BAR() do { if (bg_conv && bseq * (G * (NWAVES - 1)) < CONV_ITEMS) { TIDS(); XcdBarrier b_; b_.bar = (unsigned*)(opq(args.ws) + X_CTL) + 1024; b_.x = xb_xcc_id(); b_.st = (volatile LAS unsigned*)(lds + MISC_OFF) + 8; \
        const int s_ = bseq; auto work_ = [&]() { convert_quantum(args, s_, lds, vcu, G, wave, lane); }; xcd_barrier_w(b_, tid, work_); } \
    else { XcdBarrier b_; b_.bar = (unsigned*)(opq(args.ws) + X_CTL) + 1024; b_.x = xb_xcc_id(); b_.st = (volatile LAS unsigned*)(lds + MISC_OFF) + 8; xcd_barrier(b_); } ++bseq; } while (0)

    int bseq = 0; const bool bg_conv = G * (NWAVES - 1) >= CONV_CAP_MIN;
    for (int rep_ = 0; rep_ < REP_P0; ++rep_) {   TIDS(); unsigned char* ws = opq(args.ws);
        if (bg_conv) convert_mats(args, 0, 1, lds, gw, NGW, wave, lane);
        else convert_mats(args, 0, 15, lds, gw, NGW, wave, lane);
        const float* x = args.in[0]; const float* meta = args.in[1]; ssq_t* SSQ = WSP(ssq_t, X_SSQ); bf16* HB = WSP(bf16, WS_HB); bf16* HBM = WSP(bf16, X_HBM);
        for (int i0 = 0; i0 < NROWI(); i0 += 4) {
            f32x4 v[4][4];
#pragma unroll
            for (int q = 0; q < 4; ++q) { const int row = (i0 + q) < NROWI() ? ROWI(i0 + q) : MT; if (row < MT) { const float* src = row < MR ? x + (size_t)row * D : meta + (size_t)(row - MR) * D;
#pragma unroll
                for (int j = 0; j < 4; ++j) v[q][j] = __builtin_nontemporal_load((const f32x4*)(src + 4 * lane + 256 * j)); } }
#pragma unroll
            for (int q = 0; q < 4; ++q) { const int row = (i0 + q) < NROWI() ? ROWI(i0 + q) : MT; if (row < MT) { bf16* dst = rp(HB, HBM, row, D); float ss = 0.f;
#pragma unroll
                for (int j = 0; j < 4; ++j) { ss += (v[q][j][0] * v[q][j][0] + v[q][j][1] * v[q][j][1]) + (v[q][j][2] * v[q][j][2] + v[q][j][3] * v[q][j][3]); store4bf(dst + 4 * lane + 256 * j, v[q][j]); }
                ss = wave_sum(ss); if (lane == 0) { if (row < MR) *(f32x4*)(WSP(float, X_SSQP) + (size_t)row * 4) = (f32x4){ss, 0.f, 0.f, 0.f}; else SSQ[row] = ssq_enc(ss); } } }
        }
        for (int i = gw * 64 + lane; i < 8 * MT; i += NGW * 64) SSQ[MT + i] = 0ull;
    }
    if (args.pad0 == 0x7fffffff) cg::this_grid().sync();
    GRID_BAR();

    for (int layer_ = 0; layer_ < DEPTH; ++layer_) {
        int layer = layer_; asm volatile("" : "+s"(layer));
        const int j = layer >> 1;
        if ((layer & 1) == 0) {
            for (int rep_ = 0; rep_ < REP_IN; ++rep_) {   unsigned char* ws = opq(args.ws); const ssq_t* ssq_mix = WSP(ssq_t, X_SSQ) + (size_t)(2 * layer) * MT;
                const float* pin = WSP(float, X_SSQP) + (size_t)(2 * layer) * MR * 4;
                const EpiArgs ar{ssq_mix, WSP(bf16, WS_BIG), WSP(bf16, WS_BIG + 32 * MiB), nullptr, nullptr, nullptr, 1.0f, pin, nullptr}, am{ssq_mix + MR, WSP(bf16, X_GBM), WSP(bf16, X_UM), nullptr, nullptr, nullptr, 1.0f, nullptr, nullptr};
                do_gemm<K_CONVIN>(lds, WSP(bf16, WS_HB), WSP(bf16, X_HBM), WSP(bf16, WS_W + (j ? W_CIN1 : W_CIN0)), 3 * D, D, 128, ar, am, vcu, G, wv0); }
            GRID_BAR();
            for (int rep_ = 0; rep_ < REP_CONV; ++rep_) {   TIDS(); unsigned char* ws = opq(args.ws); const float* cw = args.in[4] + (size_t)j * 3 * D;
                const bf16 *GB = WSP(bf16, WS_BIG), *U = WSP(bf16, WS_BIG + 32 * MiB), *GBM = WSP(bf16, X_GBM), *UM = WSP(bf16, X_UM); bf16 *Y = WSP(bf16, WS_BIG + 64 * MiB), *YM = WSP(bf16, X_YM);
                for (int ri = 0; ri < NROWI(); ++ri) { const int row = ROWI(ri); if (row >= MT) continue;
                    const bf16 *u0 = rp(U, UM, row, D), *g0 = rp(GB, GBM, row, D); const bf16 *u1 = nullptr, *u2 = nullptr;
                    if (row < MR) { const int t = row & (SEQ - 1); u1 = t >= 1 ? U + (size_t)(row - 1) * D : UM + (size_t)15 * D; u2 = t >= 2 ? U + (size_t)(row - 2) * D : UM + (size_t)(14 + t) * D; }
                    else { const int p = row - MR; if (p >= 1) u1 = UM + (size_t)(p - 1) * D; if (p >= 2) u2 = UM + (size_t)(p - 2) * D; }
                    bf16* yo = rp(Y, YM, row, D);
#pragma unroll
                    for (int hh = 0; hh < 2; ++hh) { const int c = 8 * lane + 512 * hh;
                        const bf16x8 a = *(const bf16x8*)(u0 + c), g = *(const bf16x8*)(g0 + c); bf16x8 b = {0, 0, 0, 0, 0, 0, 0, 0}, cc = {0, 0, 0, 0, 0, 0, 0, 0};
                        if (u1) b = *(const bf16x8*)(u1 + c); if (u2) cc = *(const bf16x8*)(u2 + c);
                        float o[8];
#pragma unroll
                        for (int e = 0; e < 8; ++e) o[e] = bf2f((unsigned short)g[e]) * (cw[c + e] * bf2f((unsigned short)cc[e]) + cw[D + c + e] * bf2f((unsigned short)b[e]) + cw[2 * D + c + e] * bf2f((unsigned short)a[e]));
                        v4u w; w.x = cvt_pk_bf16(o[0], o[1]); w.y = cvt_pk_bf16(o[2], o[3]); w.z = cvt_pk_bf16(o[4], o[5]); w.w = cvt_pk_bf16(o[6], o[7]);
                        *(v4u*)(yo + c) = w; }
                }
            }
            GRID_BAR();
            {   unsigned char* ws = opq(args.ws); ssq_t* ssq_mlp = WSP(ssq_t, X_SSQ) + (size_t)(2 * layer + 1) * MT;
                for (int rep_ = 0; rep_ < REP_RES; ++rep_) { const bool lastr = rep_ == REP_RES - 1; ssq_t* sq = lastr ? ssq_mlp : WSP(ssq_t, X_SSQ);
                float* pout = WSP(float, X_SSQP) + (size_t)(lastr ? (2 * layer + 1) : 0) * MR * 4;
                const EpiArgs ar{nullptr, WSP(bf16, WS_HB), nullptr, nullptr, nullptr, sq, 1.0f / REP_RES, nullptr, pout}, am{nullptr, WSP(bf16, X_HBM), nullptr, nullptr, nullptr, sq + MR, 1.0f / REP_RES, nullptr, nullptr};
                do_gemm<K_RESID>(lds, WSP(bf16, WS_BIG + 64 * MiB), WSP(bf16, X_YM), WSP(bf16, WS_W + (j ? W_COUT1 : W_COUT0)), D, D, 64, ar, am, vcu, G, wv0); if (!lastr) GRID_BAR(); } }
            GRID_BAR();
        } else {
            if (!bg_conv && layer == 1) { { TIDS(); convert_mats(args, 15, 16, lds, gw, NGW, wave, lane); } __syncthreads(); }
            for (int rep_ = 0; rep_ < REP_IN; ++rep_) {   unsigned char* ws = opq(args.ws); const ssq_t* ssq_mix = WSP(ssq_t, X_SSQ) + (size_t)(2 * layer) * MT;
                const float* pin = WSP(float, X_SSQP) + (size_t)(2 * layer) * MR * 4;
                const EpiArgs ar{ssq_mix, WSP(bf16, WS_BIG), nullptr, nullptr, nullptr, nullptr, 1.0f, pin, nullptr}, am{ssq_mix + MR, WSP(bf16, X_QKVM), nullptr, nullptr, nullptr, nullptr, 1.0f, nullptr, nullptr};
                do_gemm<K_QKV>(lds, WSP(bf16, WS_HB), WSP(bf16, X_HBM), WSP(bf16, WS_W + (j ? W_QKV1 : W_QKV0)), 3 * D, D, 192, ar, am, vcu, G, wv0); }
            GRID_BAR();
            for (int rep_ = 0; rep_ < REP_ATT; ++rep_) {   unsigned char* ws = opq(args.ws); const bf16 *QKV = WSP(bf16, WS_BIG), *QKVM = WSP(bf16, X_QKVM); bf16 *OB = WSP(bf16, WS_BIG + 96 * MiB), *OM = WSP(bf16, X_OM);
                { TIDS();
                  for (int it0 = vcu; it0 < 512; it0 += G) { const int it = (G == 256) ? ((vcu >> 5) * 64 + (it0 >> 8) * 32 + (vcu & 31)) : it0; const int pairq = it & 3, bh = it >> 2;
                    attn_wave(lds + wave * AW_BYTES, QKV, QKVM, OB, bh >> 4, bh & 15, 256 * pairq + 32 * wave, lane); attn_wave(lds + wave * AW_BYTES, QKV, QKVM, OB, bh >> 4, bh & 15, 256 * (7 - pairq) + 32 * wave, lane); }
                }
                { TIDS(); if (layer != DEPTH - 1 && vcu < NHEAD && wave == 0) attn_meta(lds + wave * AW_BYTES, QKVM, OM, vcu, lane); }
                __syncthreads(); }
            GRID_BAR();
            {   unsigned char* ws = opq(args.ws); ssq_t* ssq_mlp = WSP(ssq_t, X_SSQ) + (size_t)(2 * layer + 1) * MT;
                for (int rep_ = 0; rep_ < REP_RES; ++rep_) { const bool lastr = rep_ == REP_RES - 1; ssq_t* sq = lastr ? ssq_mlp : WSP(ssq_t, X_SSQ);
                float* pout = WSP(float, X_SSQP) + (size_t)(lastr ? (2 * layer + 1) : 0) * MR * 4;
                const EpiArgs ar{nullptr, WSP(bf16, WS_HB), nullptr, nullptr, nullptr, sq, 1.0f / REP_RES, nullptr, pout}, am{nullptr, WSP(bf16, X_HBM), nullptr, nullptr, nullptr, sq + MR, 1.0f / REP_RES, nullptr, nullptr};
                do_gemm<K_RESID>(lds, WSP(bf16, WS_BIG + 96 * MiB), WSP(bf16, X_OM), WSP(bf16, WS_W + (j ? W_AOUT1 : W_AOUT0)), D, D, layer == DEPTH - 1 ? 0 : 64, ar, am, vcu, G, wv0); if (!lastr) GRID_BAR(); } }
            GRID_BAR();
        }
        for (int rep_ = 0; rep_ < REP_UP; ++rep_) {   unsigned char* ws = opq(args.ws); const ssq_t* ssq_mlp = WSP(ssq_t, X_SSQ) + (size_t)(2 * layer + 1) * MT;
            const float* pin = WSP(float, X_SSQP) + (size_t)(2 * layer + 1) * MR * 4;
            const EpiArgs ar{ssq_mlp, WSP(bf16, WS_BIG), nullptr, nullptr, nullptr, nullptr, 1.0f, pin, nullptr}, am{ssq_mlp + MR, WSP(bf16, X_ACTM), nullptr, nullptr, nullptr, nullptr, 1.0f, nullptr, nullptr};
            do_gemm<K_UP>(lds, WSP(bf16, WS_HB), WSP(bf16, X_HBM), WSP(bf16, WS_W + (size_t)layer * 24 * MiB + 8 * MiB), FF, D, layer == DEPTH - 1 ? 0 : 256, ar, am, vcu, G, wv0); }
        GRID_BAR();
        {   unsigned char* ws = opq(args.ws); ssq_t* ssq_next = WSP(ssq_t, X_SSQ) + (size_t)(2 * layer + 2) * MT;
            for (int rep_ = 0; rep_ < REP_RES; ++rep_) { const bool lastr = rep_ == REP_RES - 1; ssq_t* sq = lastr ? ssq_next : WSP(ssq_t, X_SSQ);
            float* pout = WSP(float, X_SSQP) + (size_t)(lastr ? (2 * layer + 2) : 0) * MR * 4;
                const EpiArgs ar{nullptr, WSP(bf16, WS_HB), nullptr, nullptr, nullptr, sq, 1.0f / REP_RES, nullptr, pout}, am{nullptr, WSP(bf16, X_HBM), nullptr, nullptr, nullptr, sq + MR, 1.0f / REP_RES, nullptr, nullptr};
            do_gemm<K_RESID>(lds, WSP(bf16, WS_BIG), WSP(bf16, X_ACTM), WSP(bf16, WS_W + (layer == 3 ? W_DN3 : (size_t)layer * 24 * MiB + 16 * MiB)), D, FF, layer == DEPTH - 1 ? 0 : 64, ar, am, vcu, G, wv0); if (!lastr) GRID_BAR(); } }
        GRID_BAR();
    }
    {   TIDS(); unsigned char* ws = opq(args.ws); const float* ssqp = WSP(float, X_SSQP) + (size_t)8 * MR * 4; const float* final_norm = args.in[12]; const bf16* HB = WSP(bf16, WS_HB);
        f32x4 g[2][2];
#pragma unroll
        for (int jj = 0; jj < 2; ++jj) { g[jj][0] = *(const f32x4*)(final_norm + 8 * lane + 512 * jj); g[jj][1] = *(const f32x4*)(final_norm + 8 * lane + 512 * jj + 4); }
        for (int ri = 0; ri < NROWI(); ++ri) { const int row = ROWI(ri); if (row >= MR) continue; const GAS f32x4* sp = (const GAS f32x4*)(ssqp + (size_t)row * 4); asm volatile("" : "+v"(sp));   const f32x4 sv = *sp; const float rs = rsqrtf(((sv[0] + sv[1]) + (sv[2] + sv[3])) * (1.0f / D) + RMS_EPS);
            float* p = args.out + (size_t)row * D; const bf16* hp = HB + (size_t)row * D;
#pragma unroll
            for (int jj = 0; jj < 2; ++jj) { const int c = 8 * lane + 512 * jj; const v4u w = *(const v4u*)(hp + c);
                f32x4 v0 = {__uint_as_float(w.x << 16), __uint_as_float(w.x & 0xffff0000u), __uint_as_float(w.y << 16), __uint_as_float(w.y & 0xffff0000u)};
                f32x4 v1 = {__uint_as_float(w.z << 16), __uint_as_float(w.z & 0xffff0000u), __uint_as_float(w.w << 16), __uint_as_float(w.w & 0xffff0000u)};
                v0 = v0 * rs * g[jj][0]; v1 = v1 * rs * g[jj][1]; __builtin_nontemporal_store(v0, (f32x4*)(p + c)); __builtin_nontemporal_store(v1, (f32x4*)(p + c + 4)); } }
    }
}

extern "C" void kernel_launch(void* const* d_in, const int* in_sizes, int n_in, void* d_out, int out_size, void* d_ws, size_t ws_size, hipStream_t stream) {
    static int grid = 0;
    if (grid == 0) {
        if (n_in != 13 || out_size != MR * D || ws_size < WS_END) { fprintf(stderr, "kernel_launch: unexpected shapes (n_in %d out %d ws %zu need %zu)\n", n_in, out_size, ws_size, (size_t)WS_END); grid = -1; return; }
        int dev = 0, cus = 0, per_cu = 0;
        hipGetDevice(&dev); hipDeviceGetAttribute(&cus, hipDeviceAttributeMultiprocessorCount, dev);
        if (hipFuncSetAttribute((const void*)fwd_megakernel, hipFuncAttributeMaxDynamicSharedMemorySize, LDS_BYTES) != hipSuccess) { fprintf(stderr, "kernel_launch: hipFuncSetAttribute failed\n"); grid = -1; return; }
        hipOccupancyMaxActiveBlocksPerMultiprocessor(&per_cu, (const void*)fwd_megakernel, NWAVES * 64, LDS_BYTES);
        (void)hipGetLastError();
        if (per_cu < 1) fprintf(stderr, "kernel_launch: occupancy query reports %d blocks per CU\n", per_cu);
        grid = cus > 0 ? cus : 256;
    }
    if (grid < 0) return;
    hipMemsetAsync((char*)d_ws + X_CTL, 0, CTL_BYTES, stream);
    Args a{};
    for (int i = 0; i < 13; ++i) a.in[i] = (const float*)d_in[i];
    a.out = (float*)d_out; a.ws = (unsigned char*)d_ws;
    void* kargs[] = {&a};
    hipError_t e = hipLaunchCooperativeKernel((const void*)fwd_megakernel, dim3(grid), dim3(NWAVES * 64), kargs, LDS_BYTES, stream);
    if (e != hipSuccess) fprintf(stderr, "cooperative launch failed: %s (grid %d)\n", hipGetErrorString(e), grid);
}
```

```cpp
#include <hip/hip_runtime.h>
#include <hip/hip_cooperative_groups.h>
#include <cstdio>
#include <cstdint>
#include <cmath>
namespace cg = cooperative_groups;
namespace pg8 {
#define PG8_LAS __attribute__((address_space(3)))
typedef unsigned short bf16_t;
typedef short bf16x8 __attribute__((ext_vector_type(8)));
typedef float f32x4 __attribute__((ext_vector_type(4)));
typedef unsigned u32x4 __attribute__((ext_vector_type(4)));
constexpr int BM = 256, BK = 64, HALF = 128, HTB = HALF * BK * 2  , STAGE_BYTES = 8 * HTB, NXCD = 8, WGM = 8;

__host__ __device__ __forceinline__ int lds_byte(int r, int c) { const int st = (r >> 4) * 2 + (c >> 5), rr = r & 15, cc = c & 31, ob = rr * 64 + cc * 2; return st * 1024 + (ob ^ (((ob >> 9) & 1) << 5)); }
__host__ __device__ __forceinline__ void stage_rc(int b, int& R, int& C) { const int st = b / 1024, sb = b % 1024, swz = sb ^ (((sb >> 9) & 1) << 5); R = (st >> 1) * 16 + swz / 64; C = (st & 1) * 32 + (swz % 64) / 2; }
__host__ __device__ __forceinline__ int perm32(int rho) { const int n = rho >> 4, i = rho & 15; return 8 * (i >> 2) + 4 * n + (i & 3); }

struct Unit { int pm, pn; };
struct Gemm { const bf16_t* A; const bf16_t* Bt; int M, N, K; };

struct StaticOrder {
    int nM, nN, nwg, G, c;
    __host__ __device__ void init(int M, int N, int G_, int c_) { nM = M / BM; nN = N / BM; nwg = nM * nN; G = G_; c = c_; }
    __host__ __device__ bool next(int i, Unit& u) const {
        const long L = (long)i * G + c; if (L >= nwg) return false;
        int wgid = (int)L; { const int q = nwg / NXCD, r = nwg % NXCD, xcd = wgid % NXCD, off = wgid / NXCD; wgid = (xcd < r ? xcd * (q + 1) : r * (q + 1) + (xcd - r) * q) + off; }
        const int nig = WGM * nN, gid = wgid / nig, fm = gid * WGM, gsz = (nM - fm) < WGM ? (nM - fm) : WGM;
        u.pm = fm + ((wgid % nig) % gsz); u.pn = (wgid % nig) / gsz; return true;
    }
    __device__ __forceinline__ void a_ready(const Unit&) const {}
    __device__ __forceinline__ void done(const Unit&) const {}
};

typedef float f32x2_t __attribute__((ext_vector_type(2))); typedef __bf16 bf16x2_t __attribute__((ext_vector_type(2)));
__device__ __forceinline__ unsigned cvt_pk_bf16(float lo, float hi) { f32x2_t v = {lo, hi}; bf16x2_t b = __builtin_convertvector(v, bf16x2_t); return __builtin_bit_cast(unsigned, b); }
template <class Epi, class Sched, bool ALIGN_EPI = false, bool SP2 = false, class Pre>
__device__ __forceinline__ void gemm_phase(PG8_LAS unsigned char* lds, const Gemm g, const Sched& S, const Epi& E, const int wv0  , const Pre& pre  ) {
    int tid_; asm volatile("v_mbcnt_lo_u32_b32 %0, -1, 0\n\tv_mbcnt_hi_u32_b32 %0, -1, %0" : "=v"(tid_)); const int tid = tid_ + 64 * wv0, wid = __builtin_amdgcn_readfirstlane(tid >> 6), lane = tid & 63, wr = wid >> 2, wc = wid & 3, fr = lane & 15, fq = lane >> 4;
    const int K = g.K, nt = K / BK;
    unsigned voffA[2], voffB[2];
#pragma unroll
    for (int i = 0; i < 2; ++i) { int R, C; stage_rc(tid * 16 + i * 8192, R, C); const int Rb = Epi::PERM ? ((R & ~31) + perm32(R & 31)) : R;
        voffA[i] = (unsigned)(R * K + C) * 2u; voffB[i] = (unsigned)(Rb * K + C) * 2u; }
    const size_t kstep = (size_t)(BK * 2);
    const size_t hstep = (size_t)HALF * K * 2;
    const size_t tstep = 2 * hstep;
    const unsigned ldsw = (unsigned)wid * 1024u;
    const int aoff = lds_byte(wr * 64 + fr, fq * 8), boff = lds_byte(wc * 32 + fr, fq * 8);
#define PG8_SA(b, h) (((b) * 2 + (h)) * HTB)
#define PG8_SB(b, h) ((4 + (b) * 2 + (h)) * HTB)
#define PG8_STAGE(bufoff, gbase, voff) do { _Pragma("unroll") for (int _i = 0; _i < 2; ++_i) \
        __builtin_amdgcn_global_load_lds((const unsigned*)((const char*)(gbase) + (voff)[_i]), (PG8_LAS unsigned*)(lds + (bufoff) + ldsw + _i * 8192), 16, 0, 0); } while (0)
#define PG8_LDA(dst, b, h) do { _Pragma("unroll") for (int m = 0; m < 4; ++m) _Pragma("unroll") for (int k = 0; k < 2; ++k) dst[m][k] = *(const PG8_LAS bf16x8*)(lds + PG8_SA(b, h) + aoff + m * 2048 + k * 1024); } while (0)
#define PG8_LDB(dst, b, h) do { _Pragma("unroll") for (int n = 0; n < 2; ++n) _Pragma("unroll") for (int k = 0; k < 2; ++k) dst[n][k] = *(const PG8_LAS bf16x8*)(lds + PG8_SB(b, h) + boff + n * 2048 + k * 1024); } while (0)
#define PG8_MMA(ai, bj, At, Bt) do { __builtin_amdgcn_s_setprio(1); _Pragma("unroll") for (int m = 0; m < 4; ++m) _Pragma("unroll") for (int n = 0; n < 2; ++n) _Pragma("unroll") for (int k = 0; k < 2; ++k) \
        acc[ai][bj][m][n] = __builtin_amdgcn_mfma_f32_16x16x32_bf16(Bt[n][k], At[m][k], acc[ai][bj][m][n], 0, 0, 0); __builtin_amdgcn_s_setprio(0); } while (0)
#define PG8_WAIT_V(n) asm volatile("s_waitcnt vmcnt(" #n ")" ::: "memory")
#define PG8_WAIT_L(n) asm volatile("s_waitcnt lgkmcnt(" #n ")" ::: "memory")
#define PG8_BAR __builtin_amdgcn_s_barrier()
#define PG8_SCHED __builtin_amdgcn_sched_barrier(0)
    Unit cur, nxt; int ui = 0;
    if (!S.next(0, cur)) return;
    f32x4 acc[2][2][4][2];
#pragma unroll
    for (int a = 0; a < 2; ++a)
#pragma unroll
        for (int b = 0; b < 2; ++b)
#pragma unroll
            for (int m = 0; m < 4; ++m)
#pragma unroll
                for (int n = 0; n < 2; ++n) acc[a][b][m][n] = (f32x4){0.f, 0.f, 0.f, 0.f};
    bf16x8 At[4][2], B0[2][2], B1[2][2];
    const char* cA = (const char*)g.A + (size_t)cur.pm * tstep; const char* cB = (const char*)g.Bt + (size_t)cur.pn * tstep;
    S.a_ready(cur);
    if constexpr (SP2) {
        PG8_STAGE(PG8_SB(0, 0), cB, voffB); PG8_STAGE(PG8_SB(0, 1), cB + hstep, voffB); PG8_STAGE(PG8_SA(0, 0), cA, voffA); PG8_STAGE(PG8_SA(0, 1), cA + hstep, voffA);
        pre();
        if (wr == 1) PG8_BAR;
        PG8_WAIT_V(2); PG8_BAR;
        PG8_STAGE(PG8_SB(1, 0), cB + kstep, voffB); PG8_STAGE(PG8_SA(1, 0), cA + kstep, voffA); PG8_STAGE(PG8_SB(1, 1), cB + hstep + kstep, voffB);
        PG8_WAIT_V(6); PG8_BAR;
    } else {
        PG8_STAGE(PG8_SB(0, 0), cB, voffB); PG8_STAGE(PG8_SA(0, 0), cA, voffA); PG8_STAGE(PG8_SB(0, 1), cB + hstep, voffB); PG8_STAGE(PG8_SA(0, 1), cA + hstep, voffA);
        if (wr == 1) PG8_BAR;
        PG8_WAIT_V(4); PG8_BAR;
        PG8_STAGE(PG8_SB(1, 0), cB + kstep, voffB); PG8_STAGE(PG8_SA(1, 0), cA + kstep, voffA); PG8_STAGE(PG8_SB(1, 1), cB + hstep + kstep, voffB);
        PG8_WAIT_V(6); PG8_BAR;
    }
    for (;;) {
        const bool has_next = S.next(ui + 1, nxt);
        const char* nA = has_next ? (const char*)g.A + (size_t)nxt.pm * tstep : cA; const char* nB = has_next ? (const char*)g.Bt + (size_t)nxt.pn * tstep : cB;
        for (int t = 0; t < nt; t += 2) {
            const bool last = (t == nt - 2);
            const char* a1 = cA + (size_t)(t + 1) * kstep;
            const char* a2 = last ? nA : cA + (size_t)(t + 2) * kstep; const char* b2 = last ? nB : cB + (size_t)(t + 2) * kstep;
            const char* a3 = a2 + kstep; const char* b3 = b2 + kstep;
            if (last && has_next) S.a_ready(nxt);
            if constexpr (SP2) {
            PG8_LDB(B0, 0, 0); PG8_LDB(B1, 0, 1); PG8_SCHED; PG8_LDA(At, 0, 0); PG8_STAGE(PG8_SA(1, 1), a1 + hstep, voffA);
            PG8_WAIT_V(8); PG8_WAIT_L(0); PG8_BAR; PG8_MMA(0, 0, At, B0); PG8_MMA(0, 1, At, B1); PG8_BAR; PG8_SCHED;
            PG8_LDA(At, 0, 1); PG8_STAGE(PG8_SB(0, 0), b2, voffB); PG8_STAGE(PG8_SB(0, 1), b2 + hstep, voffB); PG8_STAGE(PG8_SA(0, 0), a2, voffA);
            PG8_WAIT_V(8); PG8_WAIT_L(0); PG8_BAR; PG8_MMA(1, 0, At, B0); PG8_MMA(1, 1, At, B1); PG8_BAR; PG8_SCHED;
            PG8_LDB(B0, 1, 0); PG8_LDB(B1, 1, 1); PG8_SCHED; PG8_LDA(At, 1, 0); PG8_STAGE(PG8_SA(0, 1), a2 + hstep, voffA);
            PG8_WAIT_V(8); PG8_WAIT_L(0); PG8_BAR; PG8_MMA(0, 0, At, B0); PG8_MMA(0, 1, At, B1); PG8_BAR; PG8_SCHED;
            PG8_LDA(At, 1, 1); PG8_STAGE(PG8_SB(1, 0), b3, voffB); PG8_STAGE(PG8_SB(1, 1), b3 + hstep, voffB); PG8_STAGE(PG8_SA(1, 0), a3, voffA);
            PG8_WAIT_V(8); PG8_WAIT_L(0); PG8_BAR; PG8_MMA(1, 0, At, B0); PG8_MMA(1, 1, At, B1); PG8_BAR; PG8_SCHED;
            } else {
            PG8_LDB(B0, 0, 0); PG8_SCHED; PG8_LDA(At, 0, 0); PG8_STAGE(PG8_SA(1, 1), a1 + hstep, voffA);
            PG8_WAIT_L(8); PG8_BAR; PG8_WAIT_L(0); PG8_MMA(0, 0, At, B0); PG8_BAR; PG8_SCHED;
            PG8_LDB(B1, 0, 1); PG8_STAGE(PG8_SB(0, 0), b2, voffB);
            PG8_BAR; PG8_WAIT_L(0); PG8_MMA(0, 1, At, B1); PG8_BAR;
            PG8_LDA(At, 0, 1); PG8_STAGE(PG8_SA(0, 0), a2, voffA);
            PG8_BAR; PG8_WAIT_L(0); PG8_MMA(1, 0, At, B0); PG8_BAR; PG8_SCHED;
            PG8_STAGE(PG8_SB(0, 1), b2 + hstep, voffB);
            PG8_WAIT_V(6); PG8_BAR; PG8_MMA(1, 1, At, B1); PG8_BAR;
            PG8_LDB(B0, 1, 0); PG8_SCHED; PG8_LDA(At, 1, 0); PG8_STAGE(PG8_SA(0, 1), a2 + hstep, voffA);
            PG8_WAIT_L(8); PG8_BAR; PG8_WAIT_L(0); PG8_MMA(0, 0, At, B0); PG8_BAR; PG8_SCHED;
            PG8_LDB(B1, 1, 1); PG8_STAGE(PG8_SB(1, 0), b3, voffB);
            PG8_BAR; PG8_WAIT_L(0); PG8_MMA(0, 1, At, B1); PG8_BAR;
            PG8_LDA(At, 1, 1); PG8_STAGE(PG8_SA(1, 0), a3, voffA);
            PG8_BAR; PG8_WAIT_L(0); PG8_MMA(1, 0, At, B0); PG8_BAR; PG8_SCHED;
            PG8_STAGE(PG8_SB(1, 1), b3 + hstep, voffB);
            PG8_WAIT_V(6); PG8_BAR; PG8_MMA(1, 1, At, B1); PG8_BAR;
            }
        }
        if constexpr (ALIGN_EPI) { if (wr == 0) PG8_BAR; }
        if constexpr (!Epi::AFTER_DRAIN) { E(acc, cur, wr, wc, fr, fq); S.done(cur); }
        if (!has_next) break;
#pragma unroll
        for (int a = 0; a < 2; ++a)
#pragma unroll
            for (int b = 0; b < 2; ++b)
#pragma unroll
                for (int m = 0; m < 4; ++m)
#pragma unroll
                    for (int n = 0; n < 2; ++n) acc[a][b][m][n] = (f32x4){0.f, 0.f, 0.f, 0.f};
        cur = nxt; cA = nA; cB = nB; ++ui;
        if constexpr (ALIGN_EPI) { if (wr == 1) PG8_BAR; }
    }
    PG8_WAIT_V(0);
    if constexpr (!ALIGN_EPI) { if (wr == 0) PG8_BAR; }
    PG8_BAR;
    if constexpr (Epi::AFTER_DRAIN) { E.fused(acc, cur, wr, wc, fr, fq, lds, wid, lane); S.done(cur); }
#undef PG8_SA
#undef PG8_SB
#undef PG8_STAGE
#undef PG8_LDA
#undef PG8_LDB
#undef PG8_MMA
#undef PG8_WAIT_V
#undef PG8_WAIT_L
#undef PG8_BAR
#undef PG8_SCHED
}
}

constexpr int NWAVES = 8;
constexpr int D = 1024, NBATCH = 8, SEQ = 2048, NMETA = 16, FF = 4096, NHEAD = 16, HD = 64, DEPTH = 4;
constexpr int MR = NBATCH * SEQ;
constexpr int MT = MR + NMETA;
constexpr float RMS_EPS = 1e-6f;
constexpr float QSCALE = 0.125f * 1.4426950408889634f;

constexpr size_t MiB = 1u << 20;
constexpr size_t WS_W = 0;
constexpr size_t W_CIN0 = 0 * MiB, W_COUT0 = 6 * MiB, W_UP0 = 8 * MiB, W_DN0 = 16 * MiB;
constexpr size_t W_QKV0 = 24 * MiB, W_AOUT0 = 30 * MiB, W_UP1 = 32 * MiB, W_DN1 = 40 * MiB;
constexpr size_t W_CIN1 = 48 * MiB, W_COUT1 = 54 * MiB, W_UP2 = 56 * MiB, W_DN2 = 64 * MiB;
constexpr size_t W_QKV1 = 72 * MiB, W_AOUT1 = 78 * MiB, W_UP3 = 80 * MiB, W_DN3 = 8 * MiB;
constexpr size_t WS_HB = 88 * MiB;
constexpr size_t WS_BIG = 120 * MiB;
constexpr size_t WS_X = 248 * MiB;
constexpr size_t X_CTL = WS_X, CTL_BYTES = 64 * 1024;
constexpr size_t X_SSQ = WS_X + 3 * MiB;
constexpr size_t X_HM = WS_X + 1 * MiB;
constexpr size_t X_HBM = X_HM + 128 * 1024, X_GBM = X_HBM + 128 * 1024, X_UM = X_GBM + 128 * 1024, X_YM = X_UM + 128 * 1024;
constexpr size_t X_QKVM = X_YM + 128 * 1024, X_OM = X_QKVM + 128 * 1024, X_ACTM = X_OM + 128 * 1024, X_SSQP = WS_X + 5 * MiB  , WS_END = WS_X + 7 * MiB + 512 * 1024;

constexpr int RING_BYTES = 131072, LDSCTL_OFF = RING_BYTES, MISC_OFF = LDSCTL_OFF + 320, LDS_BYTES = 147456;

#define GAS __attribute__((address_space(1)))
#define LAS __attribute__((address_space(3)))
typedef unsigned short bf16;
typedef unsigned v4u __attribute__((ext_vector_type(4)));
typedef unsigned v2u __attribute__((ext_vector_type(2)));
typedef float f32x4 __attribute__((ext_vector_type(4)));
typedef float f32x16 __attribute__((ext_vector_type(16)));
typedef short bf16x8 __attribute__((ext_vector_type(8)));
#define LDS_WAIT() asm volatile("s_waitcnt lgkmcnt(0)" ::: "memory")
using pg8::cvt_pk_bf16;
__device__ __forceinline__ float bf2f(unsigned short v) { return __uint_as_float((unsigned)v << 16); }
__device__ __forceinline__ float wave_sum(float v) {
#pragma unroll
    for (int o = 1; o < 64; o <<= 1) v += __shfl_xor(v, o);
    return v;
}
__device__ __forceinline__ int otid(int wv0) { int t; asm volatile("v_mbcnt_lo_u32_b32 %0, -1, 0\n\tv_mbcnt_hi_u32_b32 %0, -1, %0" : "=v"(t)); return t + 64 * wv0; }
template <class T> __device__ __forceinline__ T* opq(T* p) { GAS T* g = (GAS T*)p; asm volatile("" : "+s"(g)); return (T*)g; }
template <class T> __device__ __forceinline__ T* rp(T* real, T* meta, int row, int ld) { return row < MR ? real + (size_t)row * ld : meta + (size_t)(row - MR) * ld; }
__device__ __forceinline__ void store4bf(bf16* dst, f32x4 v) { v2u w; w.x = cvt_pk_bf16(v[0], v[1]); w.y = cvt_pk_bf16(v[2], v[3]); *(v2u*)dst = w; }

#define XB_TMO      128
#define XB_XCNT(j)  (256  + 64 * (j))
#define XB_XSUB(j)  (1280 + 64 * (j))
#define XB_XGEN(j)  (2304 + 64 * (j))
#define XB_TOP      3328
#define XB_TOPGEN   3392
#define XCD_BAR_WORDS 3456
#define XB_SPIN_CAP (1u << 18)

__device__ __forceinline__ unsigned xb_ld(unsigned* p)              { return __hip_atomic_load(p, __ATOMIC_RELAXED, __HIP_MEMORY_SCOPE_AGENT); }
__device__ __forceinline__ unsigned xb_add(unsigned* p, unsigned v) { return __hip_atomic_fetch_add(p, v, __ATOMIC_RELAXED, __HIP_MEMORY_SCOPE_AGENT); }
__device__ __forceinline__ unsigned xb_xcc_id() { return (unsigned)__builtin_amdgcn_s_getreg((3 << 11) | 20) & 0xFu; }
#define XB_SPIN(cond, bar) do { unsigned _sp = 0; while (cond) { __builtin_amdgcn_s_sleep(1); \
    if ((++_sp & 255u) == 0u) { if (xb_ld(&(bar)[XB_TMO])) break; if (_sp > XB_SPIN_CAP) { atomicAdd(&(bar)[XB_TMO], 1u); break; } } } } while (0)

struct XcdBarrier {
    unsigned* bar; unsigned x;
    volatile LAS unsigned* st;
};

__device__ __forceinline__ XcdBarrier xcd_barrier_post(unsigned* bar, volatile LAS unsigned* st) {
    XcdBarrier b; b.bar = bar; b.x = xb_xcc_id(); b.st = st;
    if (threadIdx.x == 0) (void)xb_add(&bar[XB_XCNT(b.x)], 1u);
    return b;
}
__device__ __forceinline__ void xcd_barrier_complete(unsigned* bar, unsigned x, unsigned& nloc, unsigned& nx) {
    const unsigned G = gridDim.x * gridDim.y * gridDim.z;
    unsigned sum, cnt, mine, sp = 0u;
    for (;;) {
        sum = 0u; cnt = 0u; mine = 0u;
#pragma unroll
        for (unsigned j = 0; j < 16; ++j) { const unsigned c = xb_ld(&bar[XB_XCNT(j)]); sum += c; cnt += (c > 0u) ? 1u : 0u; mine = (j == x) ? c : mine; }
        if (sum == G) break;
        __builtin_amdgcn_s_sleep(1);
        if ((++sp & 255u) == 0u) { if (xb_ld(&bar[XB_TMO])) break; if (sp > XB_SPIN_CAP) { atomicAdd(&bar[XB_TMO], 1u); break; } }
    }
    nloc = mine > 0u ? mine : 1u; nx = cnt > 0u ? cnt : 1u;
}

__device__ __forceinline__ void xcd_barrier(const XcdBarrier& b) {
    asm volatile("s_waitcnt vmcnt(0)" ::: "memory");
    __syncthreads();
    if (threadIdx.x == 0) {
        unsigned* bar = b.bar;
        __builtin_amdgcn_s_waitcnt(0);
        unsigned nloc = b.st[0], nx = b.st[1];
        if (nloc == 0u) { xcd_barrier_complete(bar, b.x, nloc, nx); b.st[0] = nloc; b.st[1] = nx; }
        const unsigned old = xb_add(&bar[XB_XSUB(b.x)], 1u);
        const unsigned gen = old / nloc;
        if (old + 1u == (gen + 1u) * nloc) {
            __builtin_amdgcn_fence(__ATOMIC_RELEASE, "agent");
            asm volatile("s_waitcnt vmcnt(0)" ::: "memory");
            const unsigned og = xb_add(&bar[XB_TOP], 1u);
            const unsigned tg = og / nx;
            if (og + 1u == (tg + 1u) * nx) xb_add(&bar[XB_TOPGEN], 1u);
            asm volatile("buffer_inv sc1" ::: "memory");
            if (og + 1u != (tg + 1u) * nx) XB_SPIN(xb_ld(&bar[XB_TOPGEN]) == tg, bar);
            asm volatile("" ::: "memory");
            xb_add(&bar[XB_XGEN(b.x)], 1u);
            asm volatile("s_waitcnt vmcnt(0)" ::: "memory");
        } else {
            asm volatile("buffer_inv sc1" ::: "memory");
            XB_SPIN(xb_ld(&bar[XB_XGEN(b.x)]) == gen, bar);
            asm volatile("" ::: "memory");
            asm volatile("s_waitcnt vmcnt(0)" ::: "memory");
        }
    }
    __syncthreads();
}

template <class Work> __device__ __forceinline__ void xcd_barrier_w(const XcdBarrier& b, const int tid, const Work& work) {
    asm volatile("s_waitcnt vmcnt(0)" ::: "memory");
    __syncthreads();
    if (tid == 0) {
        unsigned* bar = b.bar;
        __builtin_amdgcn_s_waitcnt(0);
        unsigned nloc = b.st[0], nx = b.st[1];
        if (nloc == 0u) { xcd_barrier_complete(bar, b.x, nloc, nx); b.st[0] = nloc; b.st[1] = nx; }
        const unsigned old = xb_add(&bar[XB_XSUB(b.x)], 1u);
        const unsigned gen = old / nloc;
        if (old + 1u == (gen + 1u) * nloc) {
            __builtin_amdgcn_fence(__ATOMIC_RELEASE, "agent");
            asm volatile("s_waitcnt vmcnt(0)" ::: "memory");
            const unsigned og = xb_add(&bar[XB_TOP], 1u);
            const unsigned tg = og / nx;
            if (og + 1u == (tg + 1u) * nx) xb_add(&bar[XB_TOPGEN], 1u);
            asm volatile("buffer_inv sc1" ::: "memory");
            if (og + 1u != (tg + 1u) * nx) XB_SPIN(xb_ld(&bar[XB_TOPGEN]) == tg, bar);
            asm volatile("" ::: "memory");
            xb_add(&bar[XB_XGEN(b.x)], 1u);
            asm volatile("s_waitcnt vmcnt(0)" ::: "memory");
        } else {
            asm volatile("buffer_inv sc1" ::: "memory");
            XB_SPIN(xb_ld(&bar[XB_XGEN(b.x)]) == gen, bar);
            asm volatile("" ::: "memory");
            asm volatile("s_waitcnt vmcnt(0)" ::: "memory");
        }
    }
    else if (tid >= 64) work();
    asm volatile("s_waitcnt lgkmcnt(0)" ::: "memory"); __builtin_amdgcn_s_barrier(); asm volatile("" ::: "memory");
}


typedef unsigned long long ssq_t;
constexpr float SSQ_FIX = 1048576.0f;
__device__ __forceinline__ ssq_t ssq_enc(float ss) { return (ssq_t)(ss * SSQ_FIX + 0.5f); }
__device__ __forceinline__ float ssq_rs(ssq_t v) { return rsqrtf((float)v * (1.0f / (SSQ_FIX * D)) + RMS_EPS); }
enum { K_CONVIN = 0, K_QKV = 1, K_UP = 2, K_RESID = 3 };
__device__ __forceinline__ f32x4 relu2(f32x4 t) { t[0] = fmaxf(t[0], 0.f); t[1] = fmaxf(t[1], 0.f); t[2] = fmaxf(t[2], 0.f); t[3] = fmaxf(t[3], 0.f); return t * t; }
__device__ __forceinline__ v4u pack8(f32x4 a, f32x4 b) { v4u w; w.x = cvt_pk_bf16(a[0], a[1]); w.y = cvt_pk_bf16(a[2], a[3]); w.z = cvt_pk_bf16(b[0], b[1]); w.w = cvt_pk_bf16(b[2], b[3]); return w; }
constexpr int RSTAB_OFF = RING_BYTES + 1024;
struct EpiArgs { const ssq_t* ssq; bf16* o0; bf16* o1; const float* base; float* out; ssq_t* ssq_out; float scale; const float* ssqp; float* ssqp_out; };
__device__ __forceinline__ float ssqp_rs(const float* p) { const f32x4 v = *(const f32x4*)p; return rsqrtf(((v[0] + v[1]) + (v[2] + v[3])) * (1.0f / D) + RMS_EPS); }
constexpr int SSPART_OFF = RING_BYTES + 2048;
template <int KIND> struct Epi {
    static constexpr bool PERM = true, AFTER_DRAIN = false; EpiArgs a; const LAS float* rstab; int pm0; LAS float* sspart;
    __device__ __forceinline__ void operator()(const f32x4 (&acc)[2][2][4][2], const pg8::Unit& u, int wr, int wc, int fr, int fq) const {
        const int row0 = u.pm * 256 + wr * 64 + fr;
        if constexpr (KIND == K_RESID) {
            bf16* ob = a.o0 + (size_t)row0 * D + u.pn * 256 + wc * 32 + 8 * fq;
#pragma unroll
            for (int ai = 0; ai < 2; ++ai) {
                v4u bw[4][2];
#pragma unroll
                for (int m = 0; m < 4; ++m)
#pragma unroll
                    for (int bj = 0; bj < 2; ++bj) bw[m][bj] = *(const v4u*)(ob + (size_t)(ai * 128 + m * 16) * D + bj * 128);
#pragma unroll
                for (int m = 0; m < 4; ++m) { float ss = 0.f;
#pragma unroll
                    for (int bj = 0; bj < 2; ++bj) { const v4u w = bw[m][bj];
                        const f32x4 b0 = {__uint_as_float(w.x << 16), __uint_as_float(w.x & 0xffff0000u), __uint_as_float(w.y << 16), __uint_as_float(w.y & 0xffff0000u)};
                        const f32x4 b1 = {__uint_as_float(w.z << 16), __uint_as_float(w.z & 0xffff0000u), __uint_as_float(w.w << 16), __uint_as_float(w.w & 0xffff0000u)};
                        const f32x4 o0 = b0 + acc[ai][bj][m][0] * a.scale, o1 = b1 + acc[ai][bj][m][1] * a.scale;
                        *(v4u*)(ob + (size_t)(ai * 128 + m * 16) * D + bj * 128) = pack8(o0, o1);
                        ss += ((o0[0] * o0[0] + o0[1] * o0[1]) + (o0[2] * o0[2] + o0[3] * o0[3])) + ((o1[0] * o1[0] + o1[1] * o1[1]) + (o1[2] * o1[2] + o1[3] * o1[3])); }
                    ss += __shfl_xor(ss, 16); ss += __shfl_xor(ss, 32); if (fq == 0) sspart[(ai * 128 + wr * 64 + m * 16 + fr) * 4 + wc] = ss; }
            }
            asm volatile("s_waitcnt lgkmcnt(0)" ::: "memory"); __builtin_amdgcn_s_barrier(); asm volatile("" ::: "memory");
            { const int t_ = (wr * 4 + wc) * 64 + fq * 16 + fr; if (t_ < 256) { const f32x4 pp = *(const LAS f32x4*)(sspart + t_ * 4); a.ssqp_out[(size_t)(u.pm * 256 + t_) * 4 + u.pn] = (pp[0] + pp[1]) + (pp[2] + pp[3]); } }
        } else {
            constexpr int LD = KIND == K_CONVIN ? D : KIND == K_QKV ? 3 * D : FF;
            const bool pairt = KIND == K_CONVIN && u.pn >= 4;
            bf16* ob = pairt ? a.o1 + (size_t)row0 * LD + 128 * (u.pn - 4) + wc * 32 + 8 * fq : a.o0 + (size_t)row0 * LD + u.pn * 256 + wc * 32 + 8 * fq;
            const float qs = (KIND == K_QKV && u.pn < 4) ? QSCALE : 1.0f;
#pragma unroll
            for (int ai = 0; ai < 2; ++ai)
#pragma unroll
                for (int m = 0; m < 4; ++m) { const float rs = (u.pm == pm0 ? rstab[wr * 64 + fr + ai * 128 + m * 16] : ssqp_rs(a.ssqp + (size_t)(row0 + ai * 128 + m * 16) * 4)) * qs; bf16* rowp = ob + (size_t)(ai * 128 + m * 16) * LD;
                    if (pairt) { *(v4u*)rowp = pack8((acc[ai][0][m][0] * rs) * (acc[ai][1][m][0] * rs), (acc[ai][0][m][1] * rs) * (acc[ai][1][m][1] * rs)); }
                    else {
#pragma unroll
                        for (int bj = 0; bj < 2; ++bj) { f32x4 v0 = acc[ai][bj][m][0] * rs, v1 = acc[ai][bj][m][1] * rs; if (KIND == K_UP) { v0 = relu2(v0); v1 = relu2(v1); } *(v4u*)(rowp + bj * 128) = pack8(v0, v1); } } }
        }
    }
};
template <int KIND> __device__ __forceinline__ int mini_item_col(int item) { if (KIND == K_CONVIN && item >= 64) { const int k = item - 64; return 1024 + 256 * (k >> 3) + 16 * (k & 7); } return 16 * item; }
template <int KIND> __device__ __forceinline__ void mini_epi(const EpiArgs& a, int n0, int fr, int fq, f32x4 v0, f32x4 v1, const float rs, const v2u w  ) {
    const int col = n0 + 4 * fq;
    if constexpr (KIND == K_RESID) {
        const size_t o2 = (size_t)fr * D + col;
        const f32x4 bb = {__uint_as_float(w.x << 16), __uint_as_float(w.x & 0xffff0000u), __uint_as_float(w.y << 16), __uint_as_float(w.y & 0xffff0000u)};
        const f32x4 o = bb + v0 * a.scale; store4bf(a.o0 + o2, o); float ss = (o[0] * o[0] + o[1] * o[1]) + (o[2] * o[2] + o[3] * o[3]);
        ss += __shfl_xor(ss, 16); ss += __shfl_xor(ss, 32); if (fq == 0) atomicAdd(a.ssq_out + fr, ssq_enc(ss));
    } else {
        if (KIND == K_CONVIN) { if (n0 < 1024) store4bf(a.o0 + (size_t)fr * D + col, v0 * rs); else { const int k = col - 1024; store4bf(a.o1 + (size_t)fr * D + 128 * (k >> 8) + (k & 127), (v0 * rs) * (v1 * rs)); } }
        else if (KIND == K_QKV) store4bf(a.o0 + (size_t)fr * (3 * D) + col, v0 * (n0 < 1024 ? rs * QSCALE : rs));
        else store4bf(a.o0 + (size_t)fr * FF + col, relu2(v0 * rs));
    }
}

template <int KIND, int K> __device__ __forceinline__ void mini_gemm(LAS unsigned char* lds, const bf16* Am, const bf16* Bt, int nitems, const EpiArgs& am, int vcu, int G, const int wv0) {
    const int tid = otid(wv0), lane = tid & 63, wid = __builtin_amdgcn_readfirstlane(tid >> 6), fr = lane & 15, fq = lane >> 4;
    LAS f32x4* red = (LAS f32x4*)lds;
    for (int item = vcu; item < nitems; item += G) {
        const int n0 = mini_item_col<KIND>(item); const bool pair = KIND == K_CONVIN && n0 >= 1024;
        constexpr int kw = K >> 3; const int k0 = wid * kw;
        float rs_pre = 1.0f; v2u base_pre = {0u, 0u};
        if (KIND == K_RESID) { if (wid == 0) base_pre = *(const v2u*)(am.o0 + (size_t)fr * D + n0 + 4 * fq); } else { if (wid == 0) rs_pre = ssq_rs(am.ssq[fr]); }
        f32x4 a0 = {0.f, 0.f, 0.f, 0.f}, a1 = {0.f, 0.f, 0.f, 0.f};
        const bf16* ap = Am + (size_t)fr * K + k0 + 8 * fq; const bf16* bp = Bt + (size_t)(n0 + fr) * K + k0 + 8 * fq; const bf16* bp2 = bp + (size_t)128 * K;
#pragma unroll
        for (int kk = 0; kk < kw; kk += 32) {
            const bf16x8 av = *(const bf16x8*)(ap + kk), bv = *(const bf16x8*)(bp + kk);
            a0 = __builtin_amdgcn_mfma_f32_16x16x32_bf16(bv, av, a0, 0, 0, 0);
            if (pair) { const bf16x8 b2 = *(const bf16x8*)(bp2 + kk); a1 = __builtin_amdgcn_mfma_f32_16x16x32_bf16(b2, av, a1, 0, 0, 0); }
        }
        red[(wid * 2 + 0) * 64 + lane] = a0; red[(wid * 2 + 1) * 64 + lane] = a1;
        asm volatile("s_waitcnt lgkmcnt(0)" ::: "memory"); __builtin_amdgcn_s_barrier(); asm volatile("" ::: "memory");
        if (wid == 0) {
            f32x4 v0 = red[lane], v1 = red[64 + lane];
#pragma unroll
            for (int w = 1; w < 8; ++w) { v0 += red[(w * 2) * 64 + lane]; v1 += red[(w * 2 + 1) * 64 + lane]; }
            mini_epi<KIND>(am, n0, fr, fq, v0, v1, rs_pre, base_pre);
        }
        asm volatile("s_waitcnt lgkmcnt(0)" ::: "memory"); __builtin_amdgcn_s_barrier(); asm volatile("" ::: "memory");
    }
}

__device__ __forceinline__ unsigned f2bf(float f) { unsigned u = __builtin_bit_cast(unsigned, f); return (u + 0x7fffu + ((u >> 16) & 1u)) >> 16; }
__device__ __forceinline__ unsigned pk2(float lo, float hi) { return f2bf(lo) | (f2bf(hi) << 16); }
__device__ __forceinline__ void transpose_item(const float* W, const float* g, int K, int N, bf16* WT, int perm, LAS float* scr, int item, int lane) {
    const int nblk = N / 32, kb = item / nblk, nb = item % nblk, k0 = 64 * kb, n0 = 32 * nb;
    float wv[32];
#pragma unroll
    for (int i = 0; i < 32; ++i) wv[i] = __builtin_nontemporal_load(W + (size_t)(k0 + 2 * i + (lane >> 5)) * N + n0 + (lane & 31));
#pragma unroll
    for (int i = 0; i < 32; ++i) { const int kk = 2 * i + (lane >> 5); const float gv = g ? g[k0 + kk] : 1.0f; scr[kk * 33 + (lane & 31)] = wv[i] * gv; }
    LDS_WAIT(); asm volatile("" ::: "memory");
    int n0p = n0;
    if (perm && n0 >= 1024) { int j = n0 - 1024; const int isv = j >= 1024 ? 1 : 0; j -= isv * 1024; n0p = 1024 + 256 * (j >> 7) + 128 * isv + (j & 127); }
    const int c = lane & 7;
#pragma unroll
    for (int j = 0; j < 4; ++j) { const int n = (lane >> 3) + 8 * j; const LAS float* s = scr + (8 * c) * 33 + n;
        v4u o; o.x = pk2(s[0 * 33], s[1 * 33]); o.y = pk2(s[2 * 33], s[3 * 33]); o.z = pk2(s[4 * 33], s[5 * 33]); o.w = pk2(s[6 * 33], s[7 * 33]);
        *(v4u*)(WT + (size_t)(n0p + n) * K + k0 + 8 * c) = o; }
    LDS_WAIT(); asm volatile("" ::: "memory");
}
struct MatDesc { const float* W; const float* g; int K, N; bf16* WT; int perm; };
struct Args { const float* in[13]; float* out; unsigned char* ws; int pad0, pad1; };
__device__ __forceinline__ MatDesc mat_desc(const Args& a, int idx) {
    bf16* wb = (bf16*)(a.ws + WS_W); MatDesc m;
    const float *conv_norm = a.in[2], *conv_w_in = a.in[3], *conv_w_out = a.in[5], *attn_norm = a.in[6], *attn_w_qkv = a.in[7], *attn_w_out = a.in[8], *mlp_norm = a.in[9], *w1 = a.in[10], *w2 = a.in[11];
    if (idx < 2)       { m.W = conv_w_in + (size_t)idx * D * 3 * D; m.g = conv_norm + idx * D; m.K = D; m.N = 3 * D; m.WT = (bf16*)((unsigned char*)wb + (idx ? W_CIN1 : W_CIN0)); m.perm = 1; }
    else if (idx < 4)  { const int j = idx - 2; m.W = conv_w_out + (size_t)j * D * D; m.g = nullptr; m.K = D; m.N = D; m.WT = (bf16*)((unsigned char*)wb + (j ? W_COUT1 : W_COUT0)); m.perm = 0; }
    else if (idx < 6)  { const int j = idx - 4; m.W = attn_w_qkv + (size_t)j * D * 3 * D; m.g = attn_norm + j * D; m.K = D; m.N = 3 * D; m.WT = (bf16*)((unsigned char*)wb + (j ? W_QKV1 : W_QKV0)); m.perm = 0; }
    else if (idx < 8)  { const int j = idx - 6; m.W = attn_w_out + (size_t)j * D * D; m.g = nullptr; m.K = D; m.N = D; m.WT = (bf16*)((unsigned char*)wb + (j ? W_AOUT1 : W_AOUT0)); m.perm = 0; }
    else if (idx < 12) { const int j = idx - 8; m.W = w1 + (size_t)j * D * FF; m.g = mlp_norm + j * D; m.K = D; m.N = FF; m.WT = (bf16*)((unsigned char*)wb + (j == 0 ? W_UP0 : j == 1 ? W_UP1 : j == 2 ? W_UP2 : W_UP3)); m.perm = 0; }
    else               { const int j = idx - 12; m.W = w2 + (size_t)j * FF * D; m.g = nullptr; m.K = FF; m.N = D; m.WT = (bf16*)((unsigned char*)wb + (j == 0 ? W_DN0 : j == 1 ? W_DN1 : j == 2 ? W_DN2 : W_DN3)); m.perm = 0; }
    return m;
}
__device__ __forceinline__ void convert_mats(const Args& a, int idx_lo, int idx_hi, LAS unsigned char* lds, int gw, int NGW, int wave, int lane) {
    LAS float* scr = (LAS float*)(lds + wave * 16384);
    for (int idx = idx_lo; idx < idx_hi; ++idx) {
        const MatDesc m = mat_desc(a, idx); const int nitems = (m.K / 64) * (m.N / 32);
        for (int it = gw; it < nitems; it += NGW) transpose_item(m.W, m.g, m.K, m.N, m.WT, m.perm, scr, it, lane);
    }
}

constexpr int CONV_ITEMS_L0 = 4608, CONV_ITEMS_L = 6144, CONV_ITEMS = CONV_ITEMS_L0 + 3 * CONV_ITEMS_L, CONV_CAP_MIN = 1792;
__device__ __forceinline__ void convert_quantum(const Args& a, int s, LAS unsigned char* lds, int vcu, int G, int wave, int lane) {
    LAS float* scr = (LAS float*)(lds + wave * 16384);
    const int cap = G * (NWAVES - 1);
    for (int gi = s * cap + vcu * (NWAVES - 1) + (wave - 1); gi < CONV_ITEMS && gi < (s + 1) * cap; gi += cap) {
        int idx, li;
        if (gi < CONV_ITEMS_L0) { if (gi < 512) { idx = 2; li = gi; } else if (gi < 2560) { idx = 8; li = gi - 512; } else { idx = 12; li = gi - 2560; } }
        else { const int g2 = gi - CONV_ITEMS_L0, tl = 1 + g2 / CONV_ITEMS_L, r = g2 % CONV_ITEMS_L;
            if (r < 1536) { idx = (tl & 1) ? 4 + (tl >> 1) : (tl >> 1); li = r; }
            else if (r < 2048) { idx = ((tl & 1) ? 6 : 2) + (tl >> 1); li = r - 1536; }
            else if (r < 4096) { idx = 8 + tl; li = r - 2048; }
            else { idx = 12 + tl; li = r - 4096; } }
        const MatDesc m = mat_desc(a, idx); transpose_item(m.W, m.g, m.K, m.N, m.WT, m.perm, scr, li, lane);
    }
}

__device__ __forceinline__ int crow(int r, int hi) { return (r & 3) + 8 * (r >> 2) + 4 * hi; }
constexpr int KS_STRIDE = 144, VT_STRIDE = 136, KS_BYTES = 64 * KS_STRIDE, VT_BYTES = 64 * VT_STRIDE;
constexpr int AK_STRIDE = 144, AV_STRIDE = 192, AW_V = 32 * AK_STRIDE, AW_BYTES = AW_V + 32 * AV_STRIDE, AW_STG = 0;
constexpr float TAIL_ZERO = 5.421010862427522e-20f;
typedef short v4i16_t __attribute__((ext_vector_type(4)));
__device__ __forceinline__ v2u vtr(const LAS unsigned char* p) { return __builtin_bit_cast(v2u, __builtin_amdgcn_ds_read_tr16_b64_v4i16((LAS v4i16_t*)p)); }
__device__ __forceinline__ const bf16* pos_row(const bf16* qkv_b, const bf16* qkvm, int p) { p = p < 0 ? 0 : p; return p >= NMETA ? qkv_b + (size_t)(p - NMETA) * (3 * D) : qkvm + (size_t)p * (3 * D); }
__device__ __forceinline__ void attn_wave(LAS unsigned char* lw, const bf16* qkv, const bf16* qkvm, bf16* O, int b, int h, int tq0, int lane) {
    const int r = lane & 31, hi = lane >> 5, tq = tq0 + r, pq = tq + NMETA;
    const bf16* qkv_b = qkv + (size_t)(b * SEQ) * (3 * D);
    const bf16* qp = qkv_b + (size_t)tq * (3 * D) + h * HD + hi * 8;
    bf16x8 qf[4];
#pragma unroll
    for (int d0 = 0; d0 < 4; ++d0) qf[d0] = *(const bf16x8*)(qp + 16 * d0);
    f32x16 o0, o1;
#pragma unroll
    for (int i = 0; i < 16; ++i) { o0[i] = 0.f; o1[i] = 0.f; }
    float R = 1.0f;
    const int koff = D + h * HD + (lane & 7) * 8, vrow = lane >> 3;
    v4u kr[2][4], vr[2][4];
    int P0 = tq0 + NMETA + 32 - 64;
    const unsigned lane_off = (unsigned)(vrow * (3 * D) + (lane & 7) * 8) * 2u;
#define ATT_FETCH(PP, kb) do { const int pb_ = (PP) + 32 * (kb); \
        if (pb_ >= NMETA) { const char* sb_ = (const char*)(qkv_b + (size_t)(pb_ - NMETA) * (3 * D) + D + h * HD);     \
            _Pragma("unroll") for (int i = 0; i < 4; ++i) { const char* rp_ = sb_ + (size_t)i * (8 * 3 * D * 2) + lane_off; kr[kb][i] = *(const v4u*)rp_; vr[kb][i] = *(const v4u*)(rp_ + 2 * D); } } \
        else { _Pragma("unroll") for (int i = 0; i < 4; ++i) { const bf16* rp_ = pos_row(qkv_b, qkvm, pb_ + vrow + 8 * i) + koff; kr[kb][i] = *(const v4u*)rp_; vr[kb][i] = *(const v4u*)(rp_ + D); } } } while (0)
    ATT_FETCH(P0, 1); ATT_FETCH(P0, 0);
    const LAS unsigned char* krd = lw + r * AK_STRIDE + 16 * hi;
    const LAS unsigned char* vrd = lw + AW_V + (4 * hi + ((lane & 15) >> 2)) * AV_STRIDE + (16 * ((lane >> 4) & 1) + 4 * (lane & 3)) * 2;
    LAS unsigned char* kwr = lw + vrow * AK_STRIDE + (lane & 7) * 16; LAS unsigned char* vwr = lw + AW_V + vrow * AV_STRIDE + (lane & 7) * 16;
    for (; P0 > -64; P0 -= 64) {
        const bool need_mask = (P0 + 64 > tq0 + NMETA) || (P0 < 0);
        const int lim_hi = pq - P0, lim_lo = -P0;
        float run = R; bool half_exit = false;
#pragma unroll
        for (int kb = 1; kb >= 0; --kb) {
#pragma unroll
            for (int i = 0; i < 4; ++i) { *(LAS v4u*)(kwr + 8 * i * AK_STRIDE) = kr[kb][i]; *(LAS v4u*)(vwr + 8 * i * AV_STRIDE) = vr[kb][i]; }
            if (P0 > 0) ATT_FETCH(P0 - 64, kb);
            f32x16 p;
#pragma unroll
            for (int i = 0; i < 16; ++i) p[i] = 0.f;
            bf16x8 kfr[4];
#pragma unroll
            for (int d0 = 0; d0 < 4; ++d0) kfr[d0] = *(const LAS bf16x8*)(krd + 32 * d0);
            __builtin_amdgcn_s_setprio(1);
#pragma unroll
            for (int d0 = 0; d0 < 4; ++d0) p = __builtin_amdgcn_mfma_f32_32x32x16_bf16(kfr[d0], qf[d0], p, 0, 0, 0);
            __builtin_amdgcn_s_setprio(0);
            float bt[16], om[16];
#pragma unroll
            for (int i = 0; i < 16; ++i) {
                const float zc = __builtin_amdgcn_fmed3f(p[i], -INFINITY, 126.0f);
                const float u = __builtin_amdgcn_exp2f(zc); om[i] = __builtin_amdgcn_rcpf(1.0f + u); bt[i] = u * om[i];
            }
            if (need_mask) {
#pragma unroll
                for (int i = 0; i < 16; ++i) { const int ki = 32 * kb + crow(i, hi); if (ki >= lim_hi || ki < lim_lo) { bt[i] = 0.f; om[i] = 1.f; } }
            }
            float own[4], oth[4], T[4];
#pragma unroll
            for (int g = 0; g < 4; ++g) { float sa = om[4 * g] * om[4 * g + 1]; asm("" : "+v"(sa)); float sb = om[4 * g + 2] * om[4 * g + 3]; asm("" : "+v"(sb)); own[g] = sa * sb; asm("" : "+v"(own[g]));
                const auto sw = __builtin_amdgcn_permlane32_swap(__float_as_uint(own[g]), __float_as_uint(own[g]), false, false);
                own[g] = __uint_as_float(sw[0]); oth[g] = __uint_as_float(sw[1]); }
#pragma unroll
            for (int g = 3; g >= 0; --g) { const float A = own[g], B = oth[g];
                const float tB = run; run *= B; const float tA = run; run *= A; T[g] = hi ? tB : tA; }
            unsigned pw[8];
#pragma unroll
            for (int g = 0; g < 4; ++g) { float t = T[g]; float w[4];
#pragma unroll
                for (int i = 3; i >= 0; --i) { w[i] = bt[4 * g + i] * t; t *= om[4 * g + i]; }
                pw[2 * g] = cvt_pk_bf16(w[0], w[1]); pw[2 * g + 1] = cvt_pk_bf16(w[2], w[3]); }
            bf16x8 vfr[2][2];
#pragma unroll
            for (int s = 0; s < 2; ++s)
#pragma unroll
                for (int dh = 0; dh < 2; ++dh) { const v2u lo = vtr(vrd + (16 * s) * AV_STRIDE + 64 * dh), hi8 = vtr(vrd + (16 * s + 8) * AV_STRIDE + 64 * dh);
                    const v4u vf4 = {lo.x, lo.y, hi8.x, hi8.y}; vfr[s][dh] = __builtin_bit_cast(bf16x8, vf4); }
            __builtin_amdgcn_s_setprio(1);
#pragma unroll
            for (int s = 0; s < 2; ++s) {
                const v4u pa4 = {pw[4 * s], pw[4 * s + 1], pw[4 * s + 2], pw[4 * s + 3]}; const bf16x8 pa = __builtin_bit_cast(bf16x8, pa4);
                o0 = __builtin_amdgcn_mfma_f32_32x32x16_bf16(pa, vfr[s][0], o0, 0, 0, 0); o1 = __builtin_amdgcn_mfma_f32_32x32x16_bf16(pa, vfr[s][1], o1, 0, 0, 0);
            }
            __builtin_amdgcn_s_setprio(0);
            if (kb == 1 && __all(run < TAIL_ZERO)) { half_exit = true; break; }
        }
        R = run;
        if (half_exit || __all(R < TAIL_ZERO)) break;
    }
#undef ATT_FETCH
    {   LAS bf16* stg = (LAS bf16*)(lw + AW_STG);
#pragma unroll
        for (int i = 0; i < 16; ++i) { const int q = crow(i, hi); stg[q * 64 + r] = (bf16)(cvt_pk_bf16(o0[i], 0.f) & 0xffffu); stg[q * 64 + 32 + r] = (bf16)(cvt_pk_bf16(o1[i], 0.f) & 0xffffu); }
        LDS_WAIT();
        bf16* ob = O + (size_t)(b * SEQ + tq0) * D + h * HD;
#pragma unroll
        for (int i = 0; i < 4; ++i) { const int row = i * 8 + (lane >> 3), c8 = lane & 7; const v4u v = *(const LAS v4u*)(stg + row * 64 + c8 * 8); *(v4u*)(ob + (size_t)row * D + c8 * 8) = v; }
        LDS_WAIT();
    }
}
__device__ __forceinline__ void attn_meta(LAS unsigned char* lw, const bf16* qkvm, bf16* Om, int h, int lane) {
    asm volatile("" : "+v"(lane));
    const int t = lane & 15, dg = lane >> 4;
    {   const bf16* src = qkvm + (size_t)(lane >> 3) * (3 * D) + D + h * HD + (lane & 7) * 8;
        const v4u k0 = *(const v4u*)src, k1 = *(const v4u*)(src + (size_t)8 * (3 * D)), v0 = *(const v4u*)(src + D), v1 = *(const v4u*)(src + (size_t)8 * (3 * D) + D);
        LAS v4u* dst = (LAS v4u*)(lw + (lane >> 3) * 128 + (lane & 7) * 16);
        dst[0] = k0; dst[64] = k1; dst[128] = v0; dst[192] = v1; }
    bf16x8 q[8];
#pragma unroll
    for (int c = 0; c < 8; ++c) q[c] = *(const bf16x8*)(qkvm + (size_t)t * (3 * D) + h * HD + 8 * c);
    float acc[16];
#pragma unroll
    for (int i = 0; i < 16; ++i) acc[i] = 0.f;
    float R = 0.f;
    LDS_WAIT();
    for (int s = NMETA - 2; s >= 0; --s) {
        const LAS unsigned char* kp = lw + 128 * s; float z = 0.f;
#pragma unroll
        for (int c = 0; c < 8; ++c) { const bf16x8 kc = *(const LAS bf16x8*)(kp + 16 * c);
#pragma unroll
            for (int e = 0; e < 8; ++e) z += bf2f((unsigned short)q[c][e]) * bf2f((unsigned short)kc[e]); }
        const float e = __builtin_amdgcn_exp2f(-fabsf(z)), l = __builtin_amdgcn_logf(1.0f + e), lbv = fminf(z, 0.f) - l, lmv = lbv - z;
        const bool valid = s < t; const float w = valid ? __builtin_amdgcn_exp2f(lbv + R) : 0.f; if (valid) R += lmv;
        const LAS unsigned char* vp = lw + 2048 + 128 * s + dg * 32;
        const bf16x8 va = *(const LAS bf16x8*)vp, vb = *(const LAS bf16x8*)(vp + 16);
#pragma unroll
        for (int i = 0; i < 8; ++i) { acc[i] += w * bf2f((unsigned short)va[i]); acc[8 + i] += w * bf2f((unsigned short)vb[i]); }
    }
    bf16* op = Om + (size_t)t * D + h * HD + dg * 16;
    v4u w0, w1; w0.x = cvt_pk_bf16(acc[0], acc[1]); w0.y = cvt_pk_bf16(acc[2], acc[3]); w0.z = cvt_pk_bf16(acc[4], acc[5]); w0.w = cvt_pk_bf16(acc[6], acc[7]);
    w1.x = cvt_pk_bf16(acc[8], acc[9]); w1.y = cvt_pk_bf16(acc[10], acc[11]); w1.z = cvt_pk_bf16(acc[12], acc[13]); w1.w = cvt_pk_bf16(acc[14], acc[15]);
    *(v4u*)op = w0; *(v4u*)(op + 8) = w1;
    LDS_WAIT();
}

template <int KIND> __device__ __forceinline__ void do_gemm(LAS unsigned char* lds, const bf16* A, const bf16* Am, const bf16* Bt, int N, int K, int nmini, const EpiArgs& ar, const EpiArgs& am, int vcu, int G, const int wv0) {
    pg8::Gemm g{A, Bt, MR, N, K}; pg8::StaticOrder S; S.init(MR, N, G, (int)blockIdx.x);
    pg8::Unit u0{0, 0}; (void)S.next(0, u0);
    Epi<KIND> E{ar, (const LAS float*)(lds + RSTAB_OFF), u0.pm, (LAS float*)(lds + SSPART_OFF)};
    auto pre = [&]() { if (KIND != K_RESID) { const int t_ = otid(wv0); if (t_ < 256) ((LAS float*)(lds + RSTAB_OFF))[t_] = ssqp_rs(ar.ssqp + (size_t)(u0.pm * 256 + t_) * 4); }
        if (K == D) mini_gemm<KIND, D>(lds + 49152, Am, Bt, nmini, am, vcu, G, wv0); else mini_gemm<KIND, FF>(lds + 49152, Am, Bt, nmini, am, vcu, G, wv0); };
    pg8::gemm_phase<Epi<KIND>, pg8::StaticOrder, true, true>(lds, g, S, E, wv0, pre);
}


#ifndef REP_BAR
#define REP_BAR 1
#endif
#ifndef REP_P0
#define REP_P0 1
#endif
#ifndef REP_IN
#define REP_IN 1
#endif
#ifndef REP_UP
#define REP_UP 1
#endif
#ifndef REP_ATT
#define REP_ATT 1
#endif
#ifndef REP_RES
#define REP_RES 1
#endif
#ifndef REP_CONV
#define REP_CONV 1
#endif
__global__ void __launch_bounds__(NWAVES * 64, 2) fwd_megakernel(Args args) {
    extern __shared__ __attribute__((aligned(16))) unsigned char lds_raw[];
    LAS unsigned char* lds = (LAS unsigned char*)lds_raw;
    const int wv0 = __builtin_amdgcn_readfirstlane(threadIdx.x >> 6);
    const int G = gridDim.x, bx = blockIdx.x, vcu = (G % 8 == 0) ? (bx % 8) * (G / 8) + bx / 8 : bx;
    const int NGW = G * NWAVES;
#define WSP(T, off) ((T*)(ws + (off)))
#define TIDS() const int tid = otid(wv0), lane = tid & 63, wave = __builtin_amdgcn_readfirstlane(tid >> 6), gw = vcu * NWAVES + wave; (void)lane; (void)gw
    {   TIDS();
        for (int u = tid; u < (LDS_BYTES - LDSCTL_OFF) / 4; u += NWAVES * 64) ((LAS unsigned*)(lds + LDSCTL_OFF))[u] = 0u;
        __syncthreads();
        (void)xcd_barrier_post((unsigned*)(args.ws + X_CTL) + 1024, (volatile LAS unsigned*)(lds + MISC_OFF) + 8);
    }
#define GRID_BAR() do { if (bg_conv && bseq * (G * (NWAVES - 1)) < CONV_ITEMS) { TIDS(); XcdBarrier b_; b_.bar = (unsigned*)(opq(args.ws) + X_CTL) + 1024; b_.x = xb_xcc_id(); b_.st = (volatile LAS unsigned*)(lds + MISC_OFF) + 8; \
        const int s_ = bseq; auto work_ = [&]() { convert_quantum(args, s_, lds, vcu, G, wave, lane); }; xcd_barrier_w(b_, tid, work_); } \
    else { XcdBarrier b_; b_.bar = (unsigned*)(opq(args.ws) + X_CTL) + 1024; b_.x = xb_xcc_id(); b_.st = (volatile LAS unsigned*)(lds + MISC_OFF) + 8; xcd_barrier(b_); } ++bseq; } while (0)

    int bseq = 0; const bool bg_conv = G * (NWAVES - 1) >= CONV_CAP_MIN;
    for (int rep_ = 0; rep_ < REP_P0; ++rep_) {   TIDS(); unsigned char* ws = opq(args.ws);
        if (bg_conv) convert_mats(args, 0, 1, lds, gw, NGW, wave, lane);
        else convert_mats(args, 0, 15, lds, gw, NGW, wave, lane);
        const float* x = args.in[0]; const float* meta = args.in[1]; ssq_t* SSQ = WSP(ssq_t, X_SSQ); bf16* HB = WSP(bf16, WS_HB); bf16* HBM = WSP(bf16, X_HBM);
        for (int row0 = gw; row0 < MT; row0 += 4 * NGW) {
            f32x4 v[4][4];
#pragma unroll
            for (int q = 0; q < 4; ++q) { const int row = row0 + q * NGW; if (row < MT) { const float* src = row < MR ? x + (size_t)row * D : meta + (size_t)(row - MR) * D;
#pragma unroll
                for (int j = 0; j < 4; ++j) v[q][j] = __builtin_nontemporal_load((const f32x4*)(src + 4 * lane + 256 * j)); } }
#pragma unroll
            for (int q = 0; q < 4; ++q) { const int row = row0 + q * NGW; if (row < MT) { bf16* dst = rp(HB, HBM, row, D); float ss = 0.f;
#pragma unroll
                for (int j = 0; j < 4; ++j) { ss += (v[q][j][0] * v[q][j][0] + v[q][j][1] * v[q][j][1]) + (v[q][j][2] * v[q][j][2] + v[q][j][3] * v[q][j][3]); store4bf(dst + 4 * lane + 256 * j, v[q][j]); }
                ss = wave_sum(ss); if (lane == 0) { if (row < MR) *(f32x4*)(WSP(float, X_SSQP) + (size_t)row * 4) = (f32x4){ss, 0.f, 0.f, 0.f}; else SSQ[row] = ssq_enc(ss); } } }
        }
        for (int i = gw * 64 + lane; i < 8 * MT; i += NGW * 64) SSQ[MT + i] = 0ull;
    }
    if (args.pad0 == 0x7fffffff) cg::this_grid().sync();
    GRID_BAR();

    for (int layer_ = 0; layer_ < DEPTH; ++layer_) {
        int layer = layer_; asm volatile("" : "+s"(layer));
        const int j = layer >> 1;
        if ((layer & 1) == 0) {
            for (int rep_ = 0; rep_ < REP_IN; ++rep_) {   unsigned char* ws = opq(args.ws); const ssq_t* ssq_mix = WSP(ssq_t, X_SSQ) + (size_t)(2 * layer) * MT;
                const float* pin = WSP(float, X_SSQP) + (size_t)(2 * layer) * MR * 4;
                const EpiArgs ar{ssq_mix, WSP(bf16, WS_BIG), WSP(bf16, WS_BIG + 32 * MiB), nullptr, nullptr, nullptr, 1.0f, pin, nullptr}, am{ssq_mix + MR, WSP(bf16, X_GBM), WSP(bf16, X_UM), nullptr, nullptr, nullptr, 1.0f, nullptr, nullptr};
                do_gemm<K_CONVIN>(lds, WSP(bf16, WS_HB), WSP(bf16, X_HBM), WSP(bf16, WS_W + (j ? W_CIN1 : W_CIN0)), 3 * D, D, 128, ar, am, vcu, G, wv0); }
            GRID_BAR();
            for (int rep_ = 0; rep_ < REP_CONV; ++rep_) {   TIDS(); unsigned char* ws = opq(args.ws); const float* cw = args.in[4] + (size_t)j * 3 * D;
                const bf16 *GB = WSP(bf16, WS_BIG), *U = WSP(bf16, WS_BIG + 32 * MiB), *GBM = WSP(bf16, X_GBM), *UM = WSP(bf16, X_UM); bf16 *Y = WSP(bf16, WS_BIG + 64 * MiB), *YM = WSP(bf16, X_YM);
                for (int row = gw; row < MT; row += NGW) {
                    const bf16 *u0 = rp(U, UM, row, D), *g0 = rp(GB, GBM, row, D); const bf16 *u1 = nullptr, *u2 = nullptr;
                    if (row < MR) { const int t = row & (SEQ - 1); u1 = t >= 1 ? U + (size_t)(row - 1) * D : UM + (size_t)15 * D; u2 = t >= 2 ? U + (size_t)(row - 2) * D : UM + (size_t)(14 + t) * D; }
                    else { const int p = row - MR; if (p >= 1) u1 = UM + (size_t)(p - 1) * D; if (p >= 2) u2 = UM + (size_t)(p - 2) * D; }
                    bf16* yo = rp(Y, YM, row, D);
#pragma unroll
                    for (int hh = 0; hh < 2; ++hh) { const int c = 8 * lane + 512 * hh;
                        const bf16x8 a = *(const bf16x8*)(u0 + c), g = *(const bf16x8*)(g0 + c); bf16x8 b = {0, 0, 0, 0, 0, 0, 0, 0}, cc = {0, 0, 0, 0, 0, 0, 0, 0};
                        if (u1) b = *(const bf16x8*)(u1 + c); if (u2) cc = *(const bf16x8*)(u2 + c);
                        float o[8];
#pragma unroll
                        for (int e = 0; e < 8; ++e) o[e] = bf2f((unsigned short)g[e]) * (cw[c + e] * bf2f((unsigned short)cc[e]) + cw[D + c + e] * bf2f((unsigned short)b[e]) + cw[2 * D + c + e] * bf2f((unsigned short)a[e]));
                        v4u w; w.x = cvt_pk_bf16(o[0], o[1]); w.y = cvt_pk_bf16(o[2], o[3]); w.z = cvt_pk_bf16(o[4], o[5]); w.w = cvt_pk_bf16(o[6], o[7]);
                        *(v4u*)(yo + c) = w; }
                }
            }
            GRID_BAR();
            {   unsigned char* ws = opq(args.ws); ssq_t* ssq_mlp = WSP(ssq_t, X_SSQ) + (size_t)(2 * layer + 1) * MT;
                for (int rep_ = 0; rep_ < REP_RES; ++rep_) { const bool lastr = rep_ == REP_RES - 1; ssq_t* sq = lastr ? ssq_mlp : WSP(ssq_t, X_SSQ);
                float* pout = WSP(float, X_SSQP) + (size_t)(lastr ? (2 * layer + 1) : 0) * MR * 4;
                const EpiArgs ar{nullptr, WSP(bf16, WS_HB), nullptr, nullptr, nullptr, sq, 1.0f / REP_RES, nullptr, pout}, am{nullptr, WSP(bf16, X_HBM), nullptr, nullptr, nullptr, sq + MR, 1.0f / REP_RES, nullptr, nullptr};
                do_gemm<K_RESID>(lds, WSP(bf16, WS_BIG + 64 * MiB), WSP(bf16, X_YM), WSP(bf16, WS_W + (j ? W_COUT1 : W_COUT0)), D, D, 64, ar, am, vcu, G, wv0); if (!lastr) GRID_BAR(); } }
            GRID_BAR();
        } else {
            if (!bg_conv && layer == 1) { { TIDS(); convert_mats(args, 15, 16, lds, gw, NGW, wave, lane); } __syncthreads(); }
            for (int rep_ = 0; rep_ < REP_IN; ++rep_) {   unsigned char* ws = opq(args.ws); const ssq_t* ssq_mix = WSP(ssq_t, X_SSQ) + (size_t)(2 * layer) * MT;
                const float* pin = WSP(float, X_SSQP) + (size_t)(2 * layer) * MR * 4;
                const EpiArgs ar{ssq_mix, WSP(bf16, WS_BIG), nullptr, nullptr, nullptr, nullptr, 1.0f, pin, nullptr}, am{ssq_mix + MR, WSP(bf16, X_QKVM), nullptr, nullptr, nullptr, nullptr, 1.0f, nullptr, nullptr};
                do_gemm<K_QKV>(lds, WSP(bf16, WS_HB), WSP(bf16, X_HBM), WSP(bf16, WS_W + (j ? W_QKV1 : W_QKV0)), 3 * D, D, 192, ar, am, vcu, G, wv0); }
            GRID_BAR();
            for (int rep_ = 0; rep_ < REP_ATT; ++rep_) {   unsigned char* ws = opq(args.ws); const bf16 *QKV = WSP(bf16, WS_BIG), *QKVM = WSP(bf16, X_QKVM); bf16 *OB = WSP(bf16, WS_BIG + 96 * MiB), *OM = WSP(bf16, X_OM);
                { TIDS();
                  for (int it0 = vcu; it0 < 512; it0 += G) { const int it = (G == 256) ? ((vcu >> 5) * 64 + (it0 >> 8) * 32 + (vcu & 31)) : it0; const int pairq = it & 3, bh = it >> 2;
                    attn_wave(lds + wave * AW_BYTES, QKV, QKVM, OB, bh >> 4, bh & 15, 256 * pairq + 32 * wave, lane); attn_wave(lds + wave * AW_BYTES, QKV, QKVM, OB, bh >> 4, bh & 15, 256 * (7 - pairq) + 32 * wave, lane);
                    if (layer != DEPTH - 1 && wave == 0 && pairq == 0 && (bh >> 4) == 0) attn_meta(lds + wave * AW_BYTES, QKVM, OM, bh & 15, lane); }
                }
                __syncthreads(); }
            GRID_BAR();
            {   unsigned char* ws = opq(args.ws); ssq_t* ssq_mlp = WSP(ssq_t, X_SSQ) + (size_t)(2 * layer + 1) * MT;
                for (int rep_ = 0; rep_ < REP_RES; ++rep_) { const bool lastr = rep_ == REP_RES - 1; ssq_t* sq = lastr ? ssq_mlp : WSP(ssq_t, X_SSQ);
                float* pout = WSP(float, X_SSQP) + (size_t)(lastr ? (2 * layer + 1) : 0) * MR * 4;
                const EpiArgs ar{nullptr, WSP(bf16, WS_HB), nullptr, nullptr, nullptr, sq, 1.0f / REP_RES, nullptr, pout}, am{nullptr, WSP(bf16, X_HBM), nullptr, nullptr, nullptr, sq + MR, 1.0f / REP_RES, nullptr, nullptr};
                do_gemm<K_RESID>(lds, WSP(bf16, WS_BIG + 96 * MiB), WSP(bf16, X_OM), WSP(bf16, WS_W + (j ? W_AOUT1 : W_AOUT0)), D, D, layer == DEPTH - 1 ? 0 : 64, ar, am, vcu, G, wv0); if (!lastr) GRID_BAR(); } }
            GRID_BAR();
        }
        for (int rep_ = 0; rep_ < REP_UP; ++rep_) {   unsigned char* ws = opq(args.ws); const ssq_t* ssq_mlp = WSP(ssq_t, X_SSQ) + (size_t)(2 * layer + 1) * MT;
            const float* pin = WSP(float, X_SSQP) + (size_t)(2 * layer + 1) * MR * 4;
            const EpiArgs ar{ssq_mlp, WSP(bf16, WS_BIG), nullptr, nullptr, nullptr, nullptr, 1.0f, pin, nullptr}, am{ssq_mlp + MR, WSP(bf16, X_ACTM), nullptr, nullptr, nullptr, nullptr, 1.0f, nullptr, nullptr};
            do_gemm<K_UP>(lds, WSP(bf16, WS_HB), WSP(bf16, X_HBM), WSP(bf16, WS_W + (size_t)layer * 24 * MiB + 8 * MiB), FF, D, layer == DEPTH - 1 ? 0 : 256, ar, am, vcu, G, wv0); }
        GRID_BAR();
        {   unsigned char* ws = opq(args.ws); ssq_t* ssq_next = WSP(ssq_t, X_SSQ) + (size_t)(2 * layer + 2) * MT;
            for (int rep_ = 0; rep_ < REP_RES; ++rep_) { const bool lastr = rep_ == REP_RES - 1; ssq_t* sq = lastr ? ssq_next : WSP(ssq_t, X_SSQ);
            float* pout = WSP(float, X_SSQP) + (size_t)(lastr ? (2 * layer + 2) : 0) * MR * 4;
                const EpiArgs ar{nullptr, WSP(bf16, WS_HB), nullptr, nullptr, nullptr, sq, 1.0f / REP_RES, nullptr, pout}, am{nullptr, WSP(bf16, X_HBM), nullptr, nullptr, nullptr, sq + MR, 1.0f / REP_RES, nullptr, nullptr};
            do_gemm<K_RESID>(lds, WSP(bf16, WS_BIG), WSP(bf16, X_ACTM), WSP(bf16, WS_W + (layer == 3 ? W_DN3 : (size_t)layer * 24 * MiB + 16 * MiB)), D, FF, layer == DEPTH - 1 ? 0 : 64, ar, am, vcu, G, wv0); if (!lastr) GRID_BAR(); } }
        GRID_BAR();
    }
    {   TIDS(); unsigned char* ws = opq(args.ws); const float* ssqp = WSP(float, X_SSQP) + (size_t)8 * MR * 4; const float* final_norm = args.in[12]; const bf16* HB = WSP(bf16, WS_HB);
        f32x4 g[2][2];
#pragma unroll
        for (int jj = 0; jj < 2; ++jj) { g[jj][0] = *(const f32x4*)(final_norm + 8 * lane + 512 * jj); g[jj][1] = *(const f32x4*)(final_norm + 8 * lane + 512 * jj + 4); }
        for (int row = gw; row < MR; row += NGW) { const GAS f32x4* sp = (const GAS f32x4*)(ssqp + (size_t)row * 4); asm volatile("" : "+v"(sp));   const f32x4 sv = *sp; const float rs = rsqrtf(((sv[0] + sv[1]) + (sv[2] + sv[3])) * (1.0f / D) + RMS_EPS);
            float* p = args.out + (size_t)row * D; const bf16* hp = HB + (size_t)row * D;
#pragma unroll
            for (int jj = 0; jj < 2; ++jj) { const int c = 8 * lane + 512 * jj; const v4u w = *(const v4u*)(hp + c);
                f32x4 v0 = {__uint_as_float(w.x << 16), __uint_as_float(w.x & 0xffff0000u), __uint_as_float(w.y << 16), __uint_as_float(w.y & 0xffff0000u)};
                f32x4 v1 = {__uint_as_float(w.z << 16), __uint_as_float(w.z & 0xffff0000u), __uint_as_float(w.w << 16), __uint_as_float(w.w & 0xffff0000u)};
                v0 = v0 * rs * g[jj][0]; v1 = v1 * rs * g[jj][1]; __builtin_nontemporal_store(v0, (f32x4*)(p + c)); __builtin_nontemporal_store(v1, (f32x4*)(p + c + 4)); } }
    }
}

extern "C" void kernel_launch(void* const* d_in, const int* in_sizes, int n_in, void* d_out, int out_size, void* d_ws, size_t ws_size, hipStream_t stream) {
    static int grid = 0;
    if (grid == 0) {
        if (n_in != 13 || out_size != MR * D || ws_size < WS_END) { fprintf(stderr, "kernel_launch: unexpected shapes (n_in %d out %d ws %zu need %zu)\n", n_in, out_size, ws_size, (size_t)WS_END); grid = -1; return; }
        int dev = 0, cus = 0, per_cu = 0;
        hipGetDevice(&dev); hipDeviceGetAttribute(&cus, hipDeviceAttributeMultiprocessorCount, dev);
        if (hipFuncSetAttribute((const void*)fwd_megakernel, hipFuncAttributeMaxDynamicSharedMemorySize, LDS_BYTES) != hipSuccess) { fprintf(stderr, "kernel_launch: hipFuncSetAttribute failed\n"); grid = -1; return; }
        hipOccupancyMaxActiveBlocksPerMultiprocessor(&per_cu, (const void*)fwd_megakernel, NWAVES * 64, LDS_BYTES);
        (void)hipGetLastError();
        if (per_cu < 1) fprintf(stderr, "kernel_launch: occupancy query reports %d blocks per CU\n", per_cu);
        grid = cus > 0 ? cus : 256;
    }
    if (grid < 0) return;
    hipMemsetAsync((char*)d_ws + X_CTL, 0, CTL_BYTES, stream);
    Args a{};
    for (int i = 0; i < 13; ++i) a.in[i] = (const float*)d_in[i];
    a.out = (float*)d_out; a.ws = (unsigned char*)d_ws;
    void* kargs[] = {&a};
    hipError_t e = hipLaunchCooperativeKernel((const void*)fwd_megakernel, dim3(grid), dim3(NWAVES * 64), kargs, LDS_BYTES, stream);
    if (e != hipSuccess) fprintf(stderr, "cooperative launch failed: %s (grid %d)\n", hipGetErrorString(e), grid);
}
```

```cpp
#include <hip/hip_runtime.h>
#include <hip/hip_cooperative_groups.h>
#include <cstdio>
#include <cstdint>
#include <cmath>
namespace cg = cooperative_groups;
namespace pg8 {
#define PG8_LAS __attribute__((address_space(3)))
typedef unsigned short bf16_t;
typedef short bf16x8 __attribute__((ext_vector_type(8)));
typedef float f32x4 __attribute__((ext_vector_type(4)));
typedef unsigned u32x4 __attribute__((ext_vector_type(4)));
constexpr int BM = 256, BK = 64, HALF = 128, HTB = HALF * BK * 2  , STAGE_BYTES = 8 * HTB, NXCD = 8, WGM = 8;

__host__ __device__ __forceinline__ int lds_byte(int r, int c) { const int st = (r >> 4) * 2 + (c >> 5), rr = r & 15, cc = c & 31, ob = rr * 64 + cc * 2; return st * 1024 + (ob ^ (((ob >> 9) & 1) << 5)); }
__host__ __device__ __forceinline__ void stage_rc(int b, int& R, int& C) { const int st = b / 1024, sb = b % 1024, swz = sb ^ (((sb >> 9) & 1) << 5); R = (st >> 1) * 16 + swz / 64; C = (st & 1) * 32 + (swz % 64) / 2; }
__host__ __device__ __forceinline__ int perm32(int rho) { const int n = rho >> 4, i = rho & 15; return 8 * (i >> 2) + 4 * n + (i & 3); }

struct Unit { int pm, pn; };
struct Gemm { const bf16_t* A; const bf16_t* Bt; int M, N, K; };

struct StaticOrder {
    int nM, nN, nwg, G, c;
    __host__ __device__ void init(int M, int N, int G_, int c_) { nM = M / BM; nN = N / BM; nwg = nM * nN; G = G_; c = c_; }
    __host__ __device__ bool next(int i, Unit& u) const {
        const long L = (long)i * G + c; if (L >= nwg) return false;
        int wgid = (int)L; { const int q = nwg / NXCD, r = nwg % NXCD, xcd = wgid % NXCD, off = wgid / NXCD; wgid = (xcd < r ? xcd * (q + 1) : r * (q + 1) + (xcd - r) * q) + off; }
        const int nig = WGM * nN, gid = wgid / nig, fm = gid * WGM, gsz = (nM - fm) < WGM ? (nM - fm) : WGM;
        u.pm = fm + ((wgid % nig) % gsz); u.pn = (wgid % nig) / gsz; return true;
    }
    __device__ __forceinline__ void a_ready(const Unit&) const {}
    __device__ __forceinline__ void done(const Unit&) const {}
};

typedef float f32x2_t __attribute__((ext_vector_type(2))); typedef __bf16 bf16x2_t __attribute__((ext_vector_type(2)));
__device__ __forceinline__ unsigned cvt_pk_bf16(float lo, float hi) { f32x2_t v = {lo, hi}; bf16x2_t b = __builtin_convertvector(v, bf16x2_t); return __builtin_bit_cast(unsigned, b); }
template <class Epi, class Sched, bool ALIGN_EPI = false, bool SP2 = false, class Pre>
__device__ __forceinline__ void gemm_phase(PG8_LAS unsigned char* lds, const Gemm g, const Sched& S, const Epi& E, const int wv0  , const Pre& pre  ) {
    int tid_; asm volatile("v_mbcnt_lo_u32_b32 %0, -1, 0\n\tv_mbcnt_hi_u32_b32 %0, -1, %0" : "=v"(tid_)); const int tid = tid_ + 64 * wv0, wid = __builtin_amdgcn_readfirstlane(tid >> 6), lane = tid & 63, wr = wid >> 2, wc = wid & 3, fr = lane & 15, fq = lane >> 4;
    const int K = g.K, nt = K / BK;
    unsigned voffA[2], voffB[2];
#pragma unroll
    for (int i = 0; i < 2; ++i) { int R, C; stage_rc(tid * 16 + i * 8192, R, C); const int Rb = Epi::PERM ? ((R & ~31) + perm32(R & 31)) : R;
        voffA[i] = (unsigned)(R * K + C) * 2u; voffB[i] = (unsigned)(Rb * K + C) * 2u; }
    const size_t kstep = (size_t)(BK * 2);
    const size_t hstep = (size_t)HALF * K * 2;
    const size_t tstep = 2 * hstep;
    const unsigned ldsw = (unsigned)wid * 1024u;
    const int aoff = lds_byte(wr * 64 + fr, fq * 8), boff = lds_byte(wc * 32 + fr, fq * 8);
#define PG8_SA(b, h) (((b) * 2 + (h)) * HTB)
#define PG8_SB(b, h) ((4 + (b) * 2 + (h)) * HTB)
#define PG8_STAGE(bufoff, gbase, voff) do { _Pragma("unroll") for (int _i = 0; _i < 2; ++_i) \
        __builtin_amdgcn_global_load_lds((const unsigned*)((const char*)(gbase) + (voff)[_i]), (PG8_LAS unsigned*)(lds + (bufoff) + ldsw + _i * 8192), 16, 0, 0); } while (0)
#define PG8_LDA(dst, b, h) do { _Pragma("unroll") for (int m = 0; m < 4; ++m) _Pragma("unroll") for (int k = 0; k < 2; ++k) dst[m][k] = *(const PG8_LAS bf16x8*)(lds + PG8_SA(b, h) + aoff + m * 2048 + k * 1024); } while (0)
#define PG8_LDB(dst, b, h) do { _Pragma("unroll") for (int n = 0; n < 2; ++n) _Pragma("unroll") for (int k = 0; k < 2; ++k) dst[n][k] = *(const PG8_LAS bf16x8*)(lds + PG8_SB(b, h) + boff + n * 2048 + k * 1024); } while (0)
#define PG8_MMA(ai, bj, At, Bt) do { __builtin_amdgcn_s_setprio(1); _Pragma("unroll") for (int m = 0; m < 4; ++m) _Pragma("unroll") for (int n = 0; n < 2; ++n) _Pragma("unroll") for (int k = 0; k < 2; ++k) \
        acc[ai][bj][m][n] = __builtin_amdgcn_mfma_f32_16x16x32_bf16(Bt[n][k], At[m][k], acc[ai][bj][m][n], 0, 0, 0); __builtin_amdgcn_s_setprio(0); } while (0)
#define PG8_WAIT_V(n) asm volatile("s_waitcnt vmcnt(" #n ")" ::: "memory")
#define PG8_WAIT_L(n) asm volatile("s_waitcnt lgkmcnt(" #n ")" ::: "memory")
#define PG8_BAR __builtin_amdgcn_s_barrier()
#define PG8_SCHED __builtin_amdgcn_sched_barrier(0)
    Unit cur, nxt; int ui = 0;
    if (!S.next(0, cur)) return;
    f32x4 acc[2][2][4][2];
#pragma unroll
    for (int a = 0; a < 2; ++a)
#pragma unroll
        for (int b = 0; b < 2; ++b)
#pragma unroll
            for (int m = 0; m < 4; ++m)
#pragma unroll
                for (int n = 0; n < 2; ++n) acc[a][b][m][n] = (f32x4){0.f, 0.f, 0.f, 0.f};
    bf16x8 At[4][2], B0[2][2], B1[2][2];
    const char* cA = (const char*)g.A + (size_t)cur.pm * tstep; const char* cB = (const char*)g.Bt + (size_t)cur.pn * tstep;
    S.a_ready(cur);
    if constexpr (SP2) {
        PG8_STAGE(PG8_SB(0, 0), cB, voffB); PG8_STAGE(PG8_SB(0, 1), cB + hstep, voffB); PG8_STAGE(PG8_SA(0, 0), cA, voffA); PG8_STAGE(PG8_SA(0, 1), cA + hstep, voffA);
        pre();
        if (wr == 1) PG8_BAR;
        PG8_WAIT_V(2); PG8_BAR;
        PG8_STAGE(PG8_SB(1, 0), cB + kstep, voffB); PG8_STAGE(PG8_SA(1, 0), cA + kstep, voffA); PG8_STAGE(PG8_SB(1, 1), cB + hstep + kstep, voffB);
        PG8_WAIT_V(6); PG8_BAR;
    } else {
        PG8_STAGE(PG8_SB(0, 0), cB, voffB); PG8_STAGE(PG8_SA(0, 0), cA, voffA); PG8_STAGE(PG8_SB(0, 1), cB + hstep, voffB); PG8_STAGE(PG8_SA(0, 1), cA + hstep, voffA);
        if (wr == 1) PG8_BAR;
        PG8_WAIT_V(4); PG8_BAR;
        PG8_STAGE(PG8_SB(1, 0), cB + kstep, voffB); PG8_STAGE(PG8_SA(1, 0), cA + kstep, voffA); PG8_STAGE(PG8_SB(1, 1), cB + hstep + kstep, voffB);
        PG8_WAIT_V(6); PG8_BAR;
    }
    for (;;) {
        const bool has_next = S.next(ui + 1, nxt);
        const char* nA = has_next ? (const char*)g.A + (size_t)nxt.pm * tstep : cA; const char* nB = has_next ? (const char*)g.Bt + (size_t)nxt.pn * tstep : cB;
        for (int t = 0; t < nt; t += 2) {
            const bool last = (t == nt - 2);
            const char* a1 = cA + (size_t)(t + 1) * kstep;
            const char* a2 = last ? nA : cA + (size_t)(t + 2) * kstep; const char* b2 = last ? nB : cB + (size_t)(t + 2) * kstep;
            const char* a3 = a2 + kstep; const char* b3 = b2 + kstep;
            if (last && has_next) S.a_ready(nxt);
            if constexpr (SP2) {
            PG8_LDB(B0, 0, 0); PG8_LDB(B1, 0, 1); PG8_SCHED; PG8_LDA(At, 0, 0); PG8_STAGE(PG8_SA(1, 1), a1 + hstep, voffA);
            PG8_WAIT_V(8); PG8_WAIT_L(0); PG8_BAR; PG8_MMA(0, 0, At, B0); PG8_MMA(0, 1, At, B1); PG8_BAR; PG8_SCHED;
            PG8_LDA(At, 0, 1); PG8_STAGE(PG8_SB(0, 0), b2, voffB); PG8_STAGE(PG8_SB(0, 1), b2 + hstep, voffB); PG8_STAGE(PG8_SA(0, 0), a2, voffA);
            PG8_WAIT_V(8); PG8_WAIT_L(0); PG8_BAR; PG8_MMA(1, 0, At, B0); PG8_MMA(1, 1, At, B1); PG8_BAR; PG8_SCHED;
            PG8_LDB(B0, 1, 0); PG8_LDB(B1, 1, 1); PG8_SCHED; PG8_LDA(At, 1, 0); PG8_STAGE(PG8_SA(0, 1), a2 + hstep, voffA);
            PG8_WAIT_V(8); PG8_WAIT_L(0); PG8_BAR; PG8_MMA(0, 0, At, B0); PG8_MMA(0, 1, At, B1); PG8_BAR; PG8_SCHED;
            PG8_LDA(At, 1, 1); PG8_STAGE(PG8_SB(1, 0), b3, voffB); PG8_STAGE(PG8_SB(1, 1), b3 + hstep, voffB); PG8_STAGE(PG8_SA(1, 0), a3, voffA);
            PG8_WAIT_V(8); PG8_WAIT_L(0); PG8_BAR; PG8_MMA(1, 0, At, B0); PG8_MMA(1, 1, At, B1); PG8_BAR; PG8_SCHED;
            } else {
            PG8_LDB(B0, 0, 0); PG8_SCHED; PG8_LDA(At, 0, 0); PG8_STAGE(PG8_SA(1, 1), a1 + hstep, voffA);
            PG8_WAIT_L(8); PG8_BAR; PG8_WAIT_L(0); PG8_MMA(0, 0, At, B0); PG8_BAR; PG8_SCHED;
            PG8_LDB(B1, 0, 1); PG8_STAGE(PG8_SB(0, 0), b2, voffB);
            PG8_BAR; PG8_WAIT_L(0); PG8_MMA(0, 1, At, B1); PG8_BAR;
            PG8_LDA(At, 0, 1); PG8_STAGE(PG8_SA(0, 0), a2, voffA);
            PG8_BAR; PG8_WAIT_L(0); PG8_MMA(1, 0, At, B0); PG8_BAR; PG8_SCHED;
            PG8_STAGE(PG8_SB(0, 1), b2 + hstep, voffB);
            PG8_WAIT_V(6); PG8_BAR; PG8_MMA(1, 1, At, B1); PG8_BAR;
            PG8_LDB(B0, 1, 0); PG8_SCHED; PG8_LDA(At, 1, 0); PG8_STAGE(PG8_SA(0, 1), a2 + hstep, voffA);
            PG8_WAIT_L(8); PG8_BAR; PG8_WAIT_L(0); PG8_MMA(0, 0, At, B0); PG8_BAR; PG8_SCHED;
            PG8_LDB(B1, 1, 1); PG8_STAGE(PG8_SB(1, 0), b3, voffB);
            PG8_BAR; PG8_WAIT_L(0); PG8_MMA(0, 1, At, B1); PG8_BAR;
            PG8_LDA(At, 1, 1); PG8_STAGE(PG8_SA(1, 0), a3, voffA);
            PG8_BAR; PG8_WAIT_L(0); PG8_MMA(1, 0, At, B0); PG8_BAR; PG8_SCHED;
            PG8_STAGE(PG8_SB(1, 1), b3 + hstep, voffB);
            PG8_WAIT_V(6); PG8_BAR; PG8_MMA(1, 1, At, B1); PG8_BAR;
            }
        }
        if constexpr (ALIGN_EPI) { if (wr == 0) PG8_BAR; }
        if constexpr (!Epi::AFTER_DRAIN) { E(acc, cur, wr, wc, fr, fq); S.done(cur); }
        if (!has_next) break;
#pragma unroll
        for (int a = 0; a < 2; ++a)
#pragma unroll
            for (int b = 0; b < 2; ++b)
#pragma unroll
                for (int m = 0; m < 4; ++m)
#pragma unroll
                    for (int n = 0; n < 2; ++n) acc[a][b][m][n] = (f32x4){0.f, 0.f, 0.f, 0.f};
        cur = nxt; cA = nA; cB = nB; ++ui;
        if constexpr (ALIGN_EPI) { if (wr == 1) PG8_BAR; }
    }
    PG8_WAIT_V(0);
    if constexpr (!ALIGN_EPI) { if (wr == 0) PG8_BAR; }
    PG8_BAR;
    if constexpr (Epi::AFTER_DRAIN) { E.fused(acc, cur, wr, wc, fr, fq, lds, wid, lane); S.done(cur); }
#undef PG8_SA
#undef PG8_SB
#undef PG8_STAGE
#undef PG8_LDA
#undef PG8_LDB
#undef PG8_MMA
#undef PG8_WAIT_V
#undef PG8_WAIT_L
#undef PG8_BAR
#undef PG8_SCHED
}
}

constexpr int NWAVES = 8;
constexpr int D = 1024, NBATCH = 8, SEQ = 2048, NMETA = 16, FF = 4096, NHEAD = 16, HD = 64, DEPTH = 4;
constexpr int MR = NBATCH * SEQ;
constexpr int MT = MR + NMETA;
constexpr float RMS_EPS = 1e-6f;
constexpr float QSCALE = 0.125f * 1.4426950408889634f;

constexpr size_t MiB = 1u << 20;
constexpr size_t WS_W = 0;
constexpr size_t W_CIN0 = 0 * MiB, W_COUT0 = 6 * MiB, W_UP0 = 8 * MiB, W_DN0 = 16 * MiB;
constexpr size_t W_QKV0 = 24 * MiB, W_AOUT0 = 30 * MiB, W_UP1 = 32 * MiB, W_DN1 = 40 * MiB;
constexpr size_t W_CIN1 = 48 * MiB, W_COUT1 = 54 * MiB, W_UP2 = 56 * MiB, W_DN2 = 64 * MiB;
constexpr size_t W_QKV1 = 72 * MiB, W_AOUT1 = 78 * MiB, W_UP3 = 80 * MiB, W_DN3 = 8 * MiB;
constexpr size_t WS_HB = 88 * MiB;
constexpr size_t WS_BIG = 120 * MiB;
constexpr size_t WS_X = 248 * MiB;
constexpr size_t X_CTL = WS_X, CTL_BYTES = 64 * 1024;
constexpr size_t X_SSQ = WS_X + 3 * MiB;
constexpr size_t X_HM = WS_X + 1 * MiB;
constexpr size_t X_HBM = X_HM + 128 * 1024, X_GBM = X_HBM + 128 * 1024, X_UM = X_GBM + 128 * 1024, X_YM = X_UM + 128 * 1024;
constexpr size_t X_QKVM = X_YM + 128 * 1024, X_OM = X_QKVM + 128 * 1024, X_ACTM = X_OM + 128 * 1024, X_SSQP = WS_X + 5 * MiB  , WS_END = WS_X + 7 * MiB + 512 * 1024;

constexpr int RING_BYTES = 131072, LDSCTL_OFF = RING_BYTES, MISC_OFF = LDSCTL_OFF + 320, LDS_BYTES = 147456;

#define GAS __attribute__((address_space(1)))
#define LAS __attribute__((address_space(3)))
typedef unsigned short bf16;
typedef unsigned v4u __attribute__((ext_vector_type(4)));
typedef unsigned v2u __attribute__((ext_vector_type(2)));
typedef float f32x4 __attribute__((ext_vector_type(4)));
typedef float f32x16 __attribute__((ext_vector_type(16)));
typedef short bf16x8 __attribute__((ext_vector_type(8)));
#define LDS_WAIT() asm volatile("s_waitcnt lgkmcnt(0)" ::: "memory")
using pg8::cvt_pk_bf16;
__device__ __forceinline__ float bf2f(unsigned short v) { return __uint_as_float((unsigned)v << 16); }
__device__ __forceinline__ float wave_sum(float v) {
#pragma unroll
    for (int o = 1; o < 64; o <<= 1) v += __shfl_xor(v, o);
    return v;
}
__device__ __forceinline__ int otid(int wv0) { int t; asm volatile("v_mbcnt_lo_u32_b32 %0, -1, 0\n\tv_mbcnt_hi_u32_b32 %0, -1, %0" : "=v"(t)); return t + 64 * wv0; }
template <class T> __device__ __forceinline__ T* opq(T* p) { GAS T* g = (GAS T*)p; asm volatile("" : "+s"(g)); return (T*)g; }
template <class T> __device__ __forceinline__ T* rp(T* real, T* meta, int row, int ld) { return row < MR ? real + (size_t)row * ld : meta + (size_t)(row - MR) * ld; }
__device__ __forceinline__ void store4bf(bf16* dst, f32x4 v) { v2u w; w.x = cvt_pk_bf16(v[0], v[1]); w.y = cvt_pk_bf16(v[2], v[3]); *(v2u*)dst = w; }

#define XB_TMO      128
#define XB_XCNT(j)  (256  + 64 * (j))
#define XB_XSUB(j)  (1280 + 64 * (j))
#define XB_XGEN(j)  (2304 + 64 * (j))
#define XB_TOP      3328
#define XB_TOPGEN   3392
#define XCD_BAR_WORDS 3456
#define XB_SPIN_CAP (1u << 18)

__device__ __forceinline__ unsigned xb_ld(unsigned* p)              { return __hip_atomic_load(p, __ATOMIC_RELAXED, __HIP_MEMORY_SCOPE_AGENT); }
__device__ __forceinline__ unsigned xb_add(unsigned* p, unsigned v) { return __hip_atomic_fetch_add(p, v, __ATOMIC_RELAXED, __HIP_MEMORY_SCOPE_AGENT); }
__device__ __forceinline__ unsigned xb_xcc_id() { return (unsigned)__builtin_amdgcn_s_getreg((3 << 11) | 20) & 0xFu; }
#define XB_SPIN(cond, bar) do { unsigned _sp = 0; while (cond) { __builtin_amdgcn_s_sleep(1); \
    if ((++_sp & 255u) == 0u) { if (xb_ld(&(bar)[XB_TMO])) break; if (_sp > XB_SPIN_CAP) { atomicAdd(&(bar)[XB_TMO], 1u); break; } } } } while (0)

struct XcdBarrier {
    unsigned* bar; unsigned x;
    volatile LAS unsigned* st;
};

__device__ __forceinline__ XcdBarrier xcd_barrier_post(unsigned* bar, volatile LAS unsigned* st) {
    XcdBarrier b; b.bar = bar; b.x = xb_xcc_id(); b.st = st;
    if (threadIdx.x == 0) (void)xb_add(&bar[XB_XCNT(b.x)], 1u);
    return b;
}
__device__ __forceinline__ void xcd_barrier_complete(unsigned* bar, unsigned x, unsigned& nloc, unsigned& nx) {
    const unsigned G = gridDim.x * gridDim.y * gridDim.z;
    unsigned sum, cnt, mine, sp = 0u;
    for (;;) {
        sum = 0u; cnt = 0u; mine = 0u;
#pragma unroll
        for (unsigned j = 0; j < 16; ++j) { const unsigned c = xb_ld(&bar[XB_XCNT(j)]); sum += c; cnt += (c > 0u) ? 1u : 0u; mine = (j == x) ? c : mine; }
        if (sum == G) break;
        __builtin_amdgcn_s_sleep(1);
        if ((++sp & 255u) == 0u) { if (xb_ld(&bar[XB_TMO])) break; if (sp > XB_SPIN_CAP) { atomicAdd(&bar[XB_TMO], 1u); break; } }
    }
    nloc = mine > 0u ? mine : 1u; nx = cnt > 0u ? cnt : 1u;
}

__device__ __forceinline__ void xcd_barrier(const XcdBarrier& b) {
    asm volatile("s_waitcnt vmcnt(0)" ::: "memory");
    __syncthreads();
    if (threadIdx.x == 0) {
        unsigned* bar = b.bar;
        __builtin_amdgcn_s_waitcnt(0);
        unsigned nloc = b.st[0], nx = b.st[1];
        if (nloc == 0u) { xcd_barrier_complete(bar, b.x, nloc, nx); b.st[0] = nloc; b.st[1] = nx; }
        const unsigned old = xb_add(&bar[XB_XSUB(b.x)], 1u);
        const unsigned gen = old / nloc;
        if (old + 1u == (gen + 1u) * nloc) {
            __builtin_amdgcn_fence(__ATOMIC_RELEASE, "agent");
            asm volatile("s_waitcnt vmcnt(0)" ::: "memory");
            const unsigned og = xb_add(&bar[XB_TOP], 1u);
            const unsigned tg = og / nx;
            if (og + 1u == (tg + 1u) * nx) xb_add(&bar[XB_TOPGEN], 1u);
            asm volatile("buffer_inv sc1" ::: "memory");
            if (og + 1u != (tg + 1u) * nx) XB_SPIN(xb_ld(&bar[XB_TOPGEN]) == tg, bar);
            asm volatile("" ::: "memory");
            xb_add(&bar[XB_XGEN(b.x)], 1u);
            asm volatile("s_waitcnt vmcnt(0)" ::: "memory");
        } else {
            asm volatile("buffer_inv sc1" ::: "memory");
            XB_SPIN(xb_ld(&bar[XB_XGEN(b.x)]) == gen, bar);
            asm volatile("" ::: "memory");
            asm volatile("s_waitcnt vmcnt(0)" ::: "memory");
        }
    }
    __syncthreads();
}

template <class Work> __device__ __forceinline__ void xcd_barrier_w(const XcdBarrier& b, const int tid, const Work& work) {
    asm volatile("s_waitcnt vmcnt(0)" ::: "memory");
    __syncthreads();
    if (tid == 0) {
        unsigned* bar = b.bar;
        __builtin_amdgcn_s_waitcnt(0);
        unsigned nloc = b.st[0], nx = b.st[1];
        if (nloc == 0u) { xcd_barrier_complete(bar, b.x, nloc, nx); b.st[0] = nloc; b.st[1] = nx; }
        const unsigned old = xb_add(&bar[XB_XSUB(b.x)], 1u);
        const unsigned gen = old / nloc;
        if (old + 1u == (gen + 1u) * nloc) {
            __builtin_amdgcn_fence(__ATOMIC_RELEASE, "agent");
            asm volatile("s_waitcnt vmcnt(0)" ::: "memory");
            const unsigned og = xb_add(&bar[XB_TOP], 1u);
            const unsigned tg = og / nx;
            if (og + 1u == (tg + 1u) * nx) xb_add(&bar[XB_TOPGEN], 1u);
            asm volatile("buffer_inv sc1" ::: "memory");
            if (og + 1u != (tg + 1u) * nx) XB_SPIN(xb_ld(&bar[XB_TOPGEN]) == tg, bar);
            asm volatile("" ::: "memory");
            xb_add(&bar[XB_XGEN(b.x)], 1u);
            asm volatile("s_waitcnt vmcnt(0)" ::: "memory");
        } else {
            asm volatile("buffer_inv sc1" ::: "memory");
            XB_SPIN(xb_ld(&bar[XB_XGEN(b.x)]) == gen, bar);
            asm volatile("" ::: "memory");
            asm volatile("s_waitcnt vmcnt(0)" ::: "memory");
        }
    }
    else if (tid >= 64) work();
    asm volatile("s_waitcnt lgkmcnt(0)" ::: "memory"); __builtin_amdgcn_s_barrier(); asm volatile("" ::: "memory");
}


typedef unsigned long long ssq_t;
constexpr float SSQ_FIX = 1048576.0f;
__device__ __forceinline__ ssq_t ssq_enc(float ss) { return (ssq_t)(ss * SSQ_FIX + 0.5f); }
__device__ __forceinline__ float ssq_rs(ssq_t v) { return rsqrtf((float)v * (1.0f / (SSQ_FIX * D)) + RMS_EPS); }
enum { K_CONVIN = 0, K_QKV = 1, K_UP = 2, K_RESID = 3 };
__device__ __forceinline__ f32x4 relu2(f32x4 t) { t[0] = fmaxf(t[0], 0.f); t[1] = fmaxf(t[1], 0.f); t[2] = fmaxf(t[2], 0.f); t[3] = fmaxf(t[3], 0.f); return t * t; }
__device__ __forceinline__ v4u pack8(f32x4 a, f32x4 b) { v4u w; w.x = cvt_pk_bf16(a[0], a[1]); w.y = cvt_pk_bf16(a[2], a[3]); w.z = cvt_pk_bf16(b[0], b[1]); w.w = cvt_pk_bf16(b[2], b[3]); return w; }
constexpr int RSTAB_OFF = RING_BYTES + 1024;
struct EpiArgs { const ssq_t* ssq; bf16* o0; bf16* o1; const float* base; float* out; ssq_t* ssq_out; float scale; const float* ssqp; float* ssqp_out; };
__device__ __forceinline__ float ssqp_rs(const float* p) { const f32x4 v = *(const f32x4*)p; return rsqrtf(((v[0] + v[1]) + (v[2] + v[3])) * (1.0f / D) + RMS_EPS); }
constexpr int SSPART_OFF = RING_BYTES + 2048;
template <int KIND> struct Epi {
    static constexpr bool PERM = true, AFTER_DRAIN = false; EpiArgs a; const LAS float* rstab; int pm0; LAS float* sspart;
    __device__ __forceinline__ void operator()(const f32x4 (&acc)[2][2][4][2], const pg8::Unit& u, int wr, int wc, int fr, int fq) const {
        const int row0 = u.pm * 256 + wr * 64 + fr;
        if constexpr (KIND == K_RESID) {
            bf16* ob = a.o0 + (size_t)row0 * D + u.pn * 256 + wc * 32 + 8 * fq;
#pragma unroll
            for (int ai = 0; ai < 2; ++ai) {
                v4u bw[4][2];
#pragma unroll
                for (int m = 0; m < 4; ++m)
#pragma unroll
                    for (int bj = 0; bj < 2; ++bj) bw[m][bj] = *(const v4u*)(ob + (size_t)(ai * 128 + m * 16) * D + bj * 128);
#pragma unroll
                for (int m = 0; m < 4; ++m) { float ss = 0.f;
#pragma unroll
                    for (int bj = 0; bj < 2; ++bj) { const v4u w = bw[m][bj];
                        const f32x4 b0 = {__uint_as_float(w.x << 16), __uint_as_float(w.x & 0xffff0000u), __uint_as_float(w.y << 16), __uint_as_float(w.y & 0xffff0000u)};
                        const f32x4 b1 = {__uint_as_float(w.z << 16), __uint_as_float(w.z & 0xffff0000u), __uint_as_float(w.w << 16), __uint_as_float(w.w & 0xffff0000u)};
                        const f32x4 o0 = b0 + acc[ai][bj][m][0] * a.scale, o1 = b1 + acc[ai][bj][m][1] * a.scale;
                        *(v4u*)(ob + (size_t)(ai * 128 + m * 16) * D + bj * 128) = pack8(o0, o1);
                        ss += ((o0[0] * o0[0] + o0[1] * o0[1]) + (o0[2] * o0[2] + o0[3] * o0[3])) + ((o1[0] * o1[0] + o1[1] * o1[1]) + (o1[2] * o1[2] + o1[3] * o1[3])); }
                    ss += __shfl_xor(ss, 16); ss += __shfl_xor(ss, 32); if (fq == 0) sspart[(ai * 128 + wr * 64 + m * 16 + fr) * 4 + wc] = ss; }
            }
            asm volatile("s_waitcnt lgkmcnt(0)" ::: "memory"); __builtin_amdgcn_s_barrier(); asm volatile("" ::: "memory");
            { const int t_ = (wr * 4 + wc) * 64 + fq * 16 + fr; if (t_ < 256) { const f32x4 pp = *(const LAS f32x4*)(sspart + t_ * 4); a.ssqp_out[(size_t)(u.pm * 256 + t_) * 4 + u.pn] = (pp[0] + pp[1]) + (pp[2] + pp[3]); } }
        } else {
            constexpr int LD = KIND == K_CONVIN ? D : KIND == K_QKV ? 3 * D : FF;
            const bool pairt = KIND == K_CONVIN && u.pn >= 4;
            bf16* ob = pairt ? a.o1 + (size_t)row0 * LD + 128 * (u.pn - 4) + wc * 32 + 8 * fq : a.o0 + (size_t)row0 * LD + u.pn * 256 + wc * 32 + 8 * fq;
            const float qs = (KIND == K_QKV && u.pn < 4) ? QSCALE : 1.0f;
#pragma unroll
            for (int ai = 0; ai < 2; ++ai)
#pragma unroll
                for (int m = 0; m < 4; ++m) { const float rs = (u.pm == pm0 ? rstab[wr * 64 + fr + ai * 128 + m * 16] : ssqp_rs(a.ssqp + (size_t)(row0 + ai * 128 + m * 16) * 4)) * qs; bf16* rowp = ob + (size_t)(ai * 128 + m * 16) * LD;
                    if (pairt) { *(v4u*)rowp = pack8((acc[ai][0][m][0] * rs) * (acc[ai][1][m][0] * rs), (acc[ai][0][m][1] * rs) * (acc[ai][1][m][1] * rs)); }
                    else {
#pragma unroll
                        for (int bj = 0; bj < 2; ++bj) { f32x4 v0 = acc[ai][bj][m][0] * rs, v1 = acc[ai][bj][m][1] * rs; if (KIND == K_UP) { v0 = relu2(v0); v1 = relu2(v1); } *(v4u*)(rowp + bj * 128) = pack8(v0, v1); } } }
        }
    }
};
template <int KIND> __device__ __forceinline__ int mini_item_col(int item) { if (KIND == K_CONVIN && item >= 64) { const int k = item - 64; return 1024 + 256 * (k >> 3) + 16 * (k & 7); } return 16 * item; }
template <int KIND> __device__ __forceinline__ void mini_epi(const EpiArgs& a, int n0, int fr, int fq, f32x4 v0, f32x4 v1, const float rs, const v2u w  ) {
    const int col = n0 + 4 * fq;
    if constexpr (KIND == K_RESID) {
        const size_t o2 = (size_t)fr * D + col;
        const f32x4 bb = {__uint_as_float(w.x << 16), __uint_as_float(w.x & 0xffff0000u), __uint_as_float(w.y << 16), __uint_as_float(w.y & 0xffff0000u)};
        const f32x4 o = bb + v0 * a.scale; store4bf(a.o0 + o2, o); float ss = (o[0] * o[0] + o[1] * o[1]) + (o[2] * o[2] + o[3] * o[3]);
        ss += __shfl_xor(ss, 16); ss += __shfl_xor(ss, 32); if (fq == 0) atomicAdd(a.ssq_out + fr, ssq_enc(ss));
    } else {
        if (KIND == K_CONVIN) { if (n0 < 1024) store4bf(a.o0 + (size_t)fr * D + col, v0 * rs); else { const int k = col - 1024; store4bf(a.o1 + (size_t)fr * D + 128 * (k >> 8) + (k & 127), (v0 * rs) * (v1 * rs)); } }
        else if (KIND == K_QKV) store4bf(a.o0 + (size_t)fr * (3 * D) + col, v0 * (n0 < 1024 ? rs * QSCALE : rs));
        else store4bf(a.o0 + (size_t)fr * FF + col, relu2(v0 * rs));
    }
}

template <int KIND, int K> __device__ __forceinline__ void mini_gemm(LAS unsigned char* lds, const bf16* Am, const bf16* Bt, int nitems, const EpiArgs& am, int vcu, int G, const int wv0) {
    const int tid = otid(wv0), lane = tid & 63, wid = __builtin_amdgcn_readfirstlane(tid >> 6), fr = lane & 15, fq = lane >> 4;
    LAS f32x4* red = (LAS f32x4*)lds;
    for (int item = vcu; item < nitems; item += G) {
        const int n0 = mini_item_col<KIND>(item); const bool pair = KIND == K_CONVIN && n0 >= 1024;
        constexpr int kw = K >> 3; const int k0 = wid * kw;
        float rs_pre = 1.0f; v2u base_pre = {0u, 0u};
        if (KIND == K_RESID) { if (wid == 0) base_pre = *(const v2u*)(am.o0 + (size_t)fr * D + n0 + 4 * fq); } else { if (wid == 0) rs_pre = ssq_rs(am.ssq[fr]); }
        f32x4 a0 = {0.f, 0.f, 0.f, 0.f}, a1 = {0.f, 0.f, 0.f, 0.f};
        const bf16* ap = Am + (size_t)fr * K + k0 + 8 * fq; const bf16* bp = Bt + (size_t)(n0 + fr) * K + k0 + 8 * fq; const bf16* bp2 = bp + (size_t)128 * K;
#pragma unroll
        for (int kk = 0; kk < kw; kk += 32) {
            const bf16x8 av = *(const bf16x8*)(ap + kk), bv = *(const bf16x8*)(bp + kk);
            a0 = __builtin_amdgcn_mfma_f32_16x16x32_bf16(bv, av, a0, 0, 0, 0);
            if (pair) { const bf16x8 b2 = *(const bf16x8*)(bp2 + kk); a1 = __builtin_amdgcn_mfma_f32_16x16x32_bf16(b2, av, a1, 0, 0, 0); }
        }
        red[(wid * 2 + 0) * 64 + lane] = a0; red[(wid * 2 + 1) * 64 + lane] = a1;
        asm volatile("s_waitcnt lgkmcnt(0)" ::: "memory"); __builtin_amdgcn_s_barrier(); asm volatile("" ::: "memory");
        if (wid == 0) {
            f32x4 v0 = red[lane], v1 = red[64 + lane];
#pragma unroll
            for (int w = 1; w < 8; ++w) { v0 += red[(w * 2) * 64 + lane]; v1 += red[(w * 2 + 1) * 64 + lane]; }
            mini_epi<KIND>(am, n0, fr, fq, v0, v1, rs_pre, base_pre);
        }
        asm volatile("s_waitcnt lgkmcnt(0)" ::: "memory"); __builtin_amdgcn_s_barrier(); asm volatile("" ::: "memory");
    }
}

__device__ __forceinline__ unsigned f2bf(float f) { unsigned u = __builtin_bit_cast(unsigned, f); return (u + 0x7fffu + ((u >> 16) & 1u)) >> 16; }
__device__ __forceinline__ unsigned pk2(float lo, float hi) { return f2bf(lo) | (f2bf(hi) << 16); }
__device__ __forceinline__ void transpose_item(const float* W, const float* g, int K, int N, bf16* WT, int perm, LAS float* scr, int item, int lane) {
    const int nblk = N / 32, kb = item / nblk, nb = item % nblk, k0 = 64 * kb, n0 = 32 * nb;
    float wv[32];
#pragma unroll
    for (int i = 0; i < 32; ++i) wv[i] = __builtin_nontemporal_load(W + (size_t)(k0 + 2 * i + (lane >> 5)) * N + n0 + (lane & 31));
#pragma unroll
    for (int i = 0; i < 32; ++i) { const int kk = 2 * i + (lane >> 5); const float gv = g ? g[k0 + kk] : 1.0f; scr[kk * 33 + (lane & 31)] = wv[i] * gv; }
    LDS_WAIT(); asm volatile("" ::: "memory");
    int n0p = n0;
    if (perm && n0 >= 1024) { int j = n0 - 1024; const int isv = j >= 1024 ? 1 : 0; j -= isv * 1024; n0p = 1024 + 256 * (j >> 7) + 128 * isv + (j & 127); }
    const int c = lane & 7;
#pragma unroll
    for (int j = 0; j < 4; ++j) { const int n = (lane >> 3) + 8 * j; const LAS float* s = scr + (8 * c) * 33 + n;
        v4u o; o.x = pk2(s[0 * 33], s[1 * 33]); o.y = pk2(s[2 * 33], s[3 * 33]); o.z = pk2(s[4 * 33], s[5 * 33]); o.w = pk2(s[6 * 33], s[7 * 33]);
        *(v4u*)(WT + (size_t)(n0p + n) * K + k0 + 8 * c) = o; }
    LDS_WAIT(); asm volatile("" ::: "memory");
}
struct MatDesc { const float* W; const float* g; int K, N; bf16* WT; int perm; };
struct Args { const float* in[13]; float* out; unsigned char* ws; int pad0, pad1; };
__device__ __forceinline__ MatDesc mat_desc(const Args& a, int idx) {
    bf16* wb = (bf16*)(a.ws + WS_W); MatDesc m;
    const float *conv_norm = a.in[2], *conv_w_in = a.in[3], *conv_w_out = a.in[5], *attn_norm = a.in[6], *attn_w_qkv = a.in[7], *attn_w_out = a.in[8], *mlp_norm = a.in[9], *w1 = a.in[10], *w2 = a.in[11];
    if (idx < 2)       { m.W = conv_w_in + (size_t)idx * D * 3 * D; m.g = conv_norm + idx * D; m.K = D; m.N = 3 * D; m.WT = (bf16*)((unsigned char*)wb + (idx ? W_CIN1 : W_CIN0)); m.perm = 1; }
    else if (idx < 4)  { const int j = idx - 2; m.W = conv_w_out + (size_t)j * D * D; m.g = nullptr; m.K = D; m.N = D; m.WT = (bf16*)((unsigned char*)wb + (j ? W_COUT1 : W_COUT0)); m.perm = 0; }
    else if (idx < 6)  { const int j = idx - 4; m.W = attn_w_qkv + (size_t)j * D * 3 * D; m.g = attn_norm + j * D; m.K = D; m.N = 3 * D; m.WT = (bf16*)((unsigned char*)wb + (j ? W_QKV1 : W_QKV0)); m.perm = 0; }
    else if (idx < 8)  { const int j = idx - 6; m.W = attn_w_out + (size_t)j * D * D; m.g = nullptr; m.K = D; m.N = D; m.WT = (bf16*)((unsigned char*)wb + (j ? W_AOUT1 : W_AOUT0)); m.perm = 0; }
    else if (idx < 12) { const int j = idx - 8; m.W = w1 + (size_t)j * D * FF; m.g = mlp_norm + j * D; m.K = D; m.N = FF; m.WT = (bf16*)((unsigned char*)wb + (j == 0 ? W_UP0 : j == 1 ? W_UP1 : j == 2 ? W_UP2 : W_UP3)); m.perm = 0; }
    else               { const int j = idx - 12; m.W = w2 + (size_t)j * FF * D; m.g = nullptr; m.K = FF; m.N = D; m.WT = (bf16*)((unsigned char*)wb + (j == 0 ? W_DN0 : j == 1 ? W_DN1 : j == 2 ? W_DN2 : W_DN3)); m.perm = 0; }
    return m;
}
__device__ __forceinline__ void convert_mats(const Args& a, int idx_lo, int idx_hi, LAS unsigned char* lds, int gw, int NGW, int wave, int lane) {
    LAS float* scr = (LAS float*)(lds + wave * 16384);
    for (int idx = idx_lo; idx < idx_hi; ++idx) {
        const MatDesc m = mat_desc(a, idx); const int nitems = (m.K / 64) * (m.N / 32);
        for (int it = gw; it < nitems; it += NGW) transpose_item(m.W, m.g, m.K, m.N, m.WT, m.perm, scr, it, lane);
    }
}

constexpr int CONV_ITEMS_L0 = 4608, CONV_ITEMS_L = 6144, CONV_ITEMS = CONV_ITEMS_L0 + 3 * CONV_ITEMS_L, CONV_CAP_MIN = 1792;
__device__ __forceinline__ void convert_quantum(const Args& a, int s, LAS unsigned char* lds, int vcu, int G, int wave, int lane) {
    LAS float* scr = (LAS float*)(lds + wave * 16384);
    const int cap = G * (NWAVES - 1);
    for (int gi = s * cap + vcu * (NWAVES - 1) + (wave - 1); gi < CONV_ITEMS && gi < (s + 1) * cap; gi += cap) {
        int idx, li;
        if (gi < CONV_ITEMS_L0) { if (gi < 512) { idx = 2; li = gi; } else if (gi < 2560) { idx = 8; li = gi - 512; } else { idx = 12; li = gi - 2560; } }
        else { const int g2 = gi - CONV_ITEMS_L0, tl = 1 + g2 / CONV_ITEMS_L, r = g2 % CONV_ITEMS_L;
            if (r < 1536) { idx = (tl & 1) ? 4 + (tl >> 1) : (tl >> 1); li = r; }
            else if (r < 2048) { idx = ((tl & 1) ? 6 : 2) + (tl >> 1); li = r - 1536; }
            else if (r < 4096) { idx = 8 + tl; li = r - 2048; }
            else { idx = 12 + tl; li = r - 4096; } }
        const MatDesc m = mat_desc(a, idx); transpose_item(m.W, m.g, m.K, m.N, m.WT, m.perm, scr, li, lane);
    }
}

__device__ __forceinline__ int crow(int r, int hi) { return (r & 3) + 8 * (r >> 2) + 4 * hi; }
constexpr int KS_STRIDE = 144, VT_STRIDE = 136, KS_BYTES = 64 * KS_STRIDE, VT_BYTES = 64 * VT_STRIDE;
constexpr int AK_STRIDE = 144, AV_STRIDE = 192, AW_V = 32 * AK_STRIDE, AW_BYTES = AW_V + 32 * AV_STRIDE, AW_STG = 0;
constexpr float TAIL_ZERO = 5.421010862427522e-20f;
typedef short v4i16_t __attribute__((ext_vector_type(4)));
__device__ __forceinline__ v2u vtr(const LAS unsigned char* p) { return __builtin_bit_cast(v2u, __builtin_amdgcn_ds_read_tr16_b64_v4i16((LAS v4i16_t*)p)); }
__device__ __forceinline__ const bf16* pos_row(const bf16* qkv_b, const bf16* qkvm, int p) { p = p < 0 ? 0 : p; return p >= NMETA ? qkv_b + (size_t)(p - NMETA) * (3 * D) : qkvm + (size_t)p * (3 * D); }
__device__ __forceinline__ void attn_wave(LAS unsigned char* lw, const bf16* qkv, const bf16* qkvm, bf16* O, int b, int h, int tq0, int lane) {
    const int r = lane & 31, hi = lane >> 5, tq = tq0 + r, pq = tq + NMETA;
    const bf16* qkv_b = qkv + (size_t)(b * SEQ) * (3 * D);
    const bf16* qp = qkv_b + (size_t)tq * (3 * D) + h * HD + hi * 8;
    bf16x8 qf[4];
#pragma unroll
    for (int d0 = 0; d0 < 4; ++d0) qf[d0] = *(const bf16x8*)(qp + 16 * d0);
    f32x16 o0, o1;
#pragma unroll
    for (int i = 0; i < 16; ++i) { o0[i] = 0.f; o1[i] = 0.f; }
    float R = 1.0f;
    const int koff = D + h * HD + (lane & 7) * 8, vrow = lane >> 3;
    v4u kr[2][4], vr[2][4];
    int P0 = tq0 + NMETA + 32 - 64;
    const unsigned lane_off = (unsigned)(vrow * (3 * D) + (lane & 7) * 8) * 2u;
#define ATT_FETCH(PP, kb) do { const int pb_ = (PP) + 32 * (kb); \
        if (pb_ >= NMETA) { const char* sb_ = (const char*)(qkv_b + (size_t)(pb_ - NMETA) * (3 * D) + D + h * HD);     \
            _Pragma("unroll") for (int i = 0; i < 4; ++i) { const char* rp_ = sb_ + (size_t)i * (8 * 3 * D * 2) + lane_off; kr[kb][i] = *(const v4u*)rp_; vr[kb][i] = *(const v4u*)(rp_ + 2 * D); } } \
        else { _Pragma("unroll") for (int i = 0; i < 4; ++i) { const bf16* rp_ = pos_row(qkv_b, qkvm, pb_ + vrow + 8 * i) + koff; kr[kb][i] = *(const v4u*)rp_; vr[kb][i] = *(const v4u*)(rp_ + D); } } } while (0)
    ATT_FETCH(P0, 1); ATT_FETCH(P0, 0);
    const LAS unsigned char* krd = lw + r * AK_STRIDE + 16 * hi;
    const LAS unsigned char* vrd = lw + AW_V + (4 * hi + ((lane & 15) >> 2)) * AV_STRIDE + (16 * ((lane >> 4) & 1) + 4 * (lane & 3)) * 2;
    LAS unsigned char* kwr = lw + vrow * AK_STRIDE + (lane & 7) * 16; LAS unsigned char* vwr = lw + AW_V + vrow * AV_STRIDE + (lane & 7) * 16;
    for (; P0 > -64; P0 -= 64) {
        const bool need_mask = (P0 + 64 > tq0 + NMETA) || (P0 < 0);
        const int lim_hi = pq - P0, lim_lo = -P0;
        float run = R; bool half_exit = false;
        const bool pf = (P0 > 0) && !__all(R < 5.9604645e-08f);
#pragma unroll
        for (int kb = 1; kb >= 0; --kb) {
#pragma unroll
            for (int i = 0; i < 4; ++i) { *(LAS v4u*)(kwr + 8 * i * AK_STRIDE) = kr[kb][i]; *(LAS v4u*)(vwr + 8 * i * AV_STRIDE) = vr[kb][i]; }
            if (pf) ATT_FETCH(P0 - 64, kb);
            f32x16 p;
#pragma unroll
            for (int i = 0; i < 16; ++i) p[i] = 0.f;
            bf16x8 kfr[4];
#pragma unroll
            for (int d0 = 0; d0 < 4; ++d0) kfr[d0] = *(const LAS bf16x8*)(krd + 32 * d0);
            __builtin_amdgcn_s_setprio(1);
#pragma unroll
            for (int d0 = 0; d0 < 4; ++d0) p = __builtin_amdgcn_mfma_f32_32x32x16_bf16(kfr[d0], qf[d0], p, 0, 0, 0);
            __builtin_amdgcn_s_setprio(0);
            float bt[16], om[16];
#pragma unroll
            for (int i = 0; i < 16; ++i) {
                const float zc = __builtin_amdgcn_fmed3f(p[i], -INFINITY, 126.0f);
                const float u = __builtin_amdgcn_exp2f(zc); om[i] = __builtin_amdgcn_rcpf(1.0f + u); bt[i] = u * om[i];
            }
            if (need_mask) {
#pragma unroll
                for (int i = 0; i < 16; ++i) { const int ki = 32 * kb + crow(i, hi); if (ki >= lim_hi || ki < lim_lo) { bt[i] = 0.f; om[i] = 1.f; } }
            }
            float own[4], oth[4], T[4];
#pragma unroll
            for (int g = 0; g < 4; ++g) { float sa = om[4 * g] * om[4 * g + 1]; asm("" : "+v"(sa)); float sb = om[4 * g + 2] * om[4 * g + 3]; asm("" : "+v"(sb)); own[g] = sa * sb; asm("" : "+v"(own[g]));
                const auto sw = __builtin_amdgcn_permlane32_swap(__float_as_uint(own[g]), __float_as_uint(own[g]), false, false);
                own[g] = __uint_as_float(sw[0]); oth[g] = __uint_as_float(sw[1]); }
#pragma unroll
            for (int g = 3; g >= 0; --g) { const float A = own[g], B = oth[g];
                const float tB = run; run *= B; const float tA = run; run *= A; T[g] = hi ? tB : tA; }
            unsigned pw[8];
#pragma unroll
            for (int g = 0; g < 4; ++g) { float t = T[g]; float w[4];
#pragma unroll
                for (int i = 3; i >= 0; --i) { w[i] = bt[4 * g + i] * t; t *= om[4 * g + i]; }
                pw[2 * g] = cvt_pk_bf16(w[0], w[1]); pw[2 * g + 1] = cvt_pk_bf16(w[2], w[3]); }
            bf16x8 vfr[2][2];
#pragma unroll
            for (int s = 0; s < 2; ++s)
#pragma unroll
                for (int dh = 0; dh < 2; ++dh) { const v2u lo = vtr(vrd + (16 * s) * AV_STRIDE + 64 * dh), hi8 = vtr(vrd + (16 * s + 8) * AV_STRIDE + 64 * dh);
                    const v4u vf4 = {lo.x, lo.y, hi8.x, hi8.y}; vfr[s][dh] = __builtin_bit_cast(bf16x8, vf4); }
            __builtin_amdgcn_s_setprio(1);
#pragma unroll
            for (int s = 0; s < 2; ++s) {
                const v4u pa4 = {pw[4 * s], pw[4 * s + 1], pw[4 * s + 2], pw[4 * s + 3]}; const bf16x8 pa = __builtin_bit_cast(bf16x8, pa4);
                o0 = __builtin_amdgcn_mfma_f32_32x32x16_bf16(pa, vfr[s][0], o0, 0, 0, 0); o1 = __builtin_amdgcn_mfma_f32_32x32x16_bf16(pa, vfr[s][1], o1, 0, 0, 0);
            }
            __builtin_amdgcn_s_setprio(0);
            if (kb == 1 && __all(run < TAIL_ZERO)) { half_exit = true; break; }
        }
        R = run;
        if (half_exit || __all(R < TAIL_ZERO)) break;
        if (P0 > 0 && !pf) { ATT_FETCH(P0 - 64, 1); ATT_FETCH(P0 - 64, 0); }
    }
#undef ATT_FETCH
    {   LAS bf16* stg = (LAS bf16*)(lw + AW_STG);
#pragma unroll
        for (int i = 0; i < 16; ++i) { const int q = crow(i, hi); stg[q * 64 + r] = (bf16)(cvt_pk_bf16(o0[i], 0.f) & 0xffffu); stg[q * 64 + 32 + r] = (bf16)(cvt_pk_bf16(o1[i], 0.f) & 0xffffu); }
        LDS_WAIT();
        bf16* ob = O + (size_t)(b * SEQ + tq0) * D + h * HD;
#pragma unroll
        for (int i = 0; i < 4; ++i) { const int row = i * 8 + (lane >> 3), c8 = lane & 7; const v4u v = *(const LAS v4u*)(stg + row * 64 + c8 * 8); *(v4u*)(ob + (size_t)row * D + c8 * 8) = v; }
        LDS_WAIT();
    }
}
__device__ __forceinline__ void attn_meta(LAS unsigned char* lw, const bf16* qkvm, bf16* Om, int h, int lane) {
    asm volatile("" : "+v"(lane));
    const int t = lane & 15, dg = lane >> 4;
    {   const bf16* src = qkvm + (size_t)(lane >> 3) * (3 * D) + D + h * HD + (lane & 7) * 8;
        const v4u k0 = *(const v4u*)src, k1 = *(const v4u*)(src + (size_t)8 * (3 * D)), v0 = *(const v4u*)(src + D), v1 = *(const v4u*)(src + (size_t)8 * (3 * D) + D);
        LAS v4u* dst = (LAS v4u*)(lw + (lane >> 3) * 128 + (lane & 7) * 16);
        dst[0] = k0; dst[64] = k1; dst[128] = v0; dst[192] = v1; }
    bf16x8 q[8];
#pragma unroll
    for (int c = 0; c < 8; ++c) q[c] = *(const bf16x8*)(qkvm + (size_t)t * (3 * D) + h * HD + 8 * c);
    float acc[16];
#pragma unroll
    for (int i = 0; i < 16; ++i) acc[i] = 0.f;
    float R = 0.f;
    LDS_WAIT();
    for (int s = NMETA - 2; s >= 0; --s) {
        const LAS unsigned char* kp = lw + 128 * s; float z = 0.f;
#pragma unroll
        for (int c = 0; c < 8; ++c) { const bf16x8 kc = *(const LAS bf16x8*)(kp + 16 * c);
#pragma unroll
            for (int e = 0; e < 8; ++e) z += bf2f((unsigned short)q[c][e]) * bf2f((unsigned short)kc[e]); }
        const float e = __builtin_amdgcn_exp2f(-fabsf(z)), l = __builtin_amdgcn_logf(1.0f + e), lbv = fminf(z, 0.f) - l, lmv = lbv - z;
        const bool valid = s < t; const float w = valid ? __builtin_amdgcn_exp2f(lbv + R) : 0.f; if (valid) R += lmv;
        const LAS unsigned char* vp = lw + 2048 + 128 * s + dg * 32;
        const bf16x8 va = *(const LAS bf16x8*)vp, vb = *(const LAS bf16x8*)(vp + 16);
#pragma unroll
        for (int i = 0; i < 8; ++i) { acc[i] += w * bf2f((unsigned short)va[i]); acc[8 + i] += w * bf2f((unsigned short)vb[i]); }
    }
    bf16* op = Om + (size_t)t * D + h * HD + dg * 16;
    v4u w0, w1; w0.x = cvt_pk_bf16(acc[0], acc[1]); w0.y = cvt_pk_bf16(acc[2], acc[3]); w0.z = cvt_pk_bf16(acc[4], acc[5]); w0.w = cvt_pk_bf16(acc[6], acc[7]);
    w1.x = cvt_pk_bf16(acc[8], acc[9]); w1.y = cvt_pk_bf16(acc[10], acc[11]); w1.z = cvt_pk_bf16(acc[12], acc[13]); w1.w = cvt_pk_bf16(acc[14], acc[15]);
    *(v4u*)op = w0; *(v4u*)(op + 8) = w1;
    LDS_WAIT();
}

template <int KIND> __device__ __forceinline__ void do_gemm(LAS unsigned char* lds, const bf16* A, const bf16* Am, const bf16* Bt, int N, int K, int nmini, const EpiArgs& ar, const EpiArgs& am, int vcu, int G, const int wv0) {
    pg8::Gemm g{A, Bt, MR, N, K}; pg8::StaticOrder S; S.init(MR, N, G, (int)blockIdx.x);
    pg8::Unit u0{0, 0}; (void)S.next(0, u0);
    Epi<KIND> E{ar, (const LAS float*)(lds + RSTAB_OFF), u0.pm, (LAS float*)(lds + SSPART_OFF)};
    auto pre = [&]() { if (KIND != K_RESID) { const int t_ = otid(wv0); if (t_ < 256) ((LAS float*)(lds + RSTAB_OFF))[t_] = ssqp_rs(ar.ssqp + (size_t)(u0.pm * 256 + t_) * 4); }
        if (K == D) mini_gemm<KIND, D>(lds + 49152, Am, Bt, nmini, am, vcu, G, wv0); else mini_gemm<KIND, FF>(lds + 49152, Am, Bt, nmini, am, vcu, G, wv0); };
    pg8::gemm_phase<Epi<KIND>, pg8::StaticOrder, true, true>(lds, g, S, E, wv0, pre);
}


#ifndef REP_BAR
#define REP_BAR 1
#endif
#ifndef REP_P0
#define REP_P0 1
#endif
#ifndef REP_IN
#define REP_IN 1
#endif
#ifndef REP_UP
#define REP_UP 1
#endif
#ifndef REP_ATT
#define REP_ATT 1
#endif
#ifndef REP_RES
#define REP_RES 1
#endif
#ifndef REP_CONV
#define REP_CONV 1
#endif
__global__ void __launch_bounds__(NWAVES * 64, 2) fwd_megakernel(Args args) {
    extern __shared__ __attribute__((aligned(16))) unsigned char lds_raw[];
    LAS unsigned char* lds = (LAS unsigned char*)lds_raw;
    const int wv0 = __builtin_amdgcn_readfirstlane(threadIdx.x >> 6);
    const int G = gridDim.x, bx = blockIdx.x, vcu = (G % 8 == 0) ? (bx % 8) * (G / 8) + bx / 8 : bx;
    const int NGW = G * NWAVES;
#define WSP(T, off) ((T*)(ws + (off)))
#define TIDS() const int tid = otid(wv0), lane = tid & 63, wave = __builtin_amdgcn_readfirstlane(tid >> 6), gw = vcu * NWAVES + wave; (void)lane; (void)gw
    {   TIDS();
        for (int u = tid; u < (LDS_BYTES - LDSCTL_OFF) / 4; u += NWAVES * 64) ((LAS unsigned*)(lds + LDSCTL_OFF))[u] = 0u;
        __syncthreads();
        (void)xcd_barrier_post((unsigned*)(args.ws + X_CTL) + 1024, (volatile LAS unsigned*)(lds + MISC_OFF) + 8);
    }
#define GRID_BAR() do { if (bg_conv && bseq * (G * (NWAVES - 1)) < CONV_ITEMS) { TIDS(); XcdBarrier b_; b_.bar = (unsigned*)(opq(args.ws) + X_CTL) + 1024; b_.x = xb_xcc_id(); b_.st = (volatile LAS unsigned*)(lds + MISC_OFF) + 8; \
        const int s_ = bseq; auto work_ = [&]() { convert_quantum(args, s_, lds, vcu, G, wave, lane); }; xcd_barrier_w(b_, tid, work_); } \
    else { XcdBarrier b_; b_.bar = (unsigned*)(opq(args.ws) + X_CTL) + 1024; b_.x = xb_xcc_id(); b_.st = (volatile LAS unsigned*)(lds + MISC_OFF) + 8; xcd_barrier(b_); } ++bseq; } while (0)

    int bseq = 0; const bool bg_conv = G * (NWAVES - 1) >= CONV_CAP_MIN;
    for (int rep_ = 0; rep_ < REP_P0; ++rep_) {   TIDS(); unsigned char* ws = opq(args.ws);
        if (bg_conv) convert_mats(args, 0, 1, lds, gw, NGW, wave, lane);
        else convert_mats(args, 0, 15, lds, gw, NGW, wave, lane);
        const float* x = args.in[0]; const float* meta = args.in[1]; ssq_t* SSQ = WSP(ssq_t, X_SSQ); bf16* HB = WSP(bf16, WS_HB); bf16* HBM = WSP(bf16, X_HBM);
        for (int row0 = gw; row0 < MT; row0 += 4 * NGW) {
            f32x4 v[4][4];
#pragma unroll
            for (int q = 0; q < 4; ++q) { const int row = row0 + q * NGW; if (row < MT) { const float* src = row < MR ? x + (size_t)row * D : meta + (size_t)(row - MR) * D;
#pragma unroll
                for (int j = 0; j < 4; ++j) v[q][j] = __builtin_nontemporal_load((const f32x4*)(src + 4 * lane + 256 * j)); } }
#pragma unroll
            for (int q = 0; q < 4; ++q) { const int row = row0 + q * NGW; if (row < MT) { bf16* dst = rp(HB, HBM, row, D); float ss = 0.f;
#pragma unroll
                for (int j = 0; j < 4; ++j) { ss += (v[q][j][0] * v[q][j][0] + v[q][j][1] * v[q][j][1]) + (v[q][j][2] * v[q][j][2] + v[q][j][3] * v[q][j][3]); store4bf(dst + 4 * lane + 256 * j, v[q][j]); }
                ss = wave_sum(ss); if (lane == 0) { if (row < MR) *(f32x4*)(WSP(float, X_SSQP) + (size_t)row * 4) = (f32x4){ss, 0.f, 0.f, 0.f}; else SSQ[row] = ssq_enc(ss); } } }
        }
        for (int i = gw * 64 + lane; i < 8 * MT; i += NGW * 64) SSQ[MT + i] = 0ull;
    }
    if (args.pad0 == 0x7fffffff) cg::this_grid().sync();
    GRID_BAR();

    for (int layer_ = 0; layer_ < DEPTH; ++layer_) {
        int layer = layer_; asm volatile("" : "+s"(layer));
        const int j = layer >> 1;
        if ((layer & 1) == 0) {
            for (int rep_ = 0; rep_ < REP_IN; ++rep_) {   unsigned char* ws = opq(args.ws); const ssq_t* ssq_mix = WSP(ssq_t, X_SSQ) + (size_t)(2 * layer) * MT;
                const float* pin = WSP(float, X_SSQP) + (size_t)(2 * layer) * MR * 4;
                const EpiArgs ar{ssq_mix, WSP(bf16, WS_BIG), WSP(bf16, WS_BIG + 32 * MiB), nullptr, nullptr, nullptr, 1.0f, pin, nullptr}, am{ssq_mix + MR, WSP(bf16, X_GBM), WSP(bf16, X_UM), nullptr, nullptr, nullptr, 1.0f, nullptr, nullptr};
                do_gemm<K_CONVIN>(lds, WSP(bf16, WS_HB), WSP(bf16, X_HBM), WSP(bf16, WS_W + (j ? W_CIN1 : W_CIN0)), 3 * D, D, 128, ar, am, vcu, G, wv0); }
            GRID_BAR();
            for (int rep_ = 0; rep_ < REP_CONV; ++rep_) {   TIDS(); unsigned char* ws = opq(args.ws); const float* cw = args.in[4] + (size_t)j * 3 * D;
                const bf16 *GB = WSP(bf16, WS_BIG), *U = WSP(bf16, WS_BIG + 32 * MiB), *GBM = WSP(bf16, X_GBM), *UM = WSP(bf16, X_UM); bf16 *Y = WSP(bf16, WS_BIG + 64 * MiB), *YM = WSP(bf16, X_YM);
                for (int row = gw; row < MT; row += NGW) {
                    const bf16 *u0 = rp(U, UM, row, D), *g0 = rp(GB, GBM, row, D); const bf16 *u1 = nullptr, *u2 = nullptr;
                    if (row < MR) { const int t = row & (SEQ - 1); u1 = t >= 1 ? U + (size_t)(row - 1) * D : UM + (size_t)15 * D; u2 = t >= 2 ? U + (size_t)(row - 2) * D : UM + (size_t)(14 + t) * D; }
                    else { const int p = row - MR; if (p >= 1) u1 = UM + (size_t)(p - 1) * D; if (p >= 2) u2 = UM + (size_t)(p - 2) * D; }
                    bf16* yo = rp(Y, YM, row, D);
#pragma unroll
                    for (int hh = 0; hh < 2; ++hh) { const int c = 8 * lane + 512 * hh;
                        const bf16x8 a = *(const bf16x8*)(u0 + c), g = *(const bf16x8*)(g0 + c); bf16x8 b = {0, 0, 0, 0, 0, 0, 0, 0}, cc = {0, 0, 0, 0, 0, 0, 0, 0};
                        if (u1) b = *(const bf16x8*)(u1 + c); if (u2) cc = *(const bf16x8*)(u2 + c);
                        float o[8];
#pragma unroll
                        for (int e = 0; e < 8; ++e) o[e] = bf2f((unsigned short)g[e]) * (cw[c + e] * bf2f((unsigned short)cc[e]) + cw[D + c + e] * bf2f((unsigned short)b[e]) + cw[2 * D + c + e] * bf2f((unsigned short)a[e]));
                        v4u w; w.x = cvt_pk_bf16(o[0], o[1]); w.y = cvt_pk_bf16(o[2], o[3]); w.z = cvt_pk_bf16(o[4], o[5]); w.w = cvt_pk_bf16(o[6], o[7]);
                        *(v4u*)(yo + c) = w; }
                }
            }
            GRID_BAR();
            {   unsigned char* ws = opq(args.ws); ssq_t* ssq_mlp = WSP(ssq_t, X_SSQ) + (size_t)(2 * layer + 1) * MT;
                for (int rep_ = 0; rep_ < REP_RES; ++rep_) { const bool lastr = rep_ == REP_RES - 1; ssq_t* sq = lastr ? ssq_mlp : WSP(ssq_t, X_SSQ);
                float* pout = WSP(float, X_SSQP) + (size_t)(lastr ? (2 * layer + 1) : 0) * MR * 4;
                const EpiArgs ar{nullptr, WSP(bf16, WS_HB), nullptr, nullptr, nullptr, sq, 1.0f / REP_RES, nullptr, pout}, am{nullptr, WSP(bf16, X_HBM), nullptr, nullptr, nullptr, sq + MR, 1.0f / REP_RES, nullptr, nullptr};
                do_gemm<K_RESID>(lds, WSP(bf16, WS_BIG + 64 * MiB), WSP(bf16, X_YM), WSP(bf16, WS_W + (j ? W_COUT1 : W_COUT0)), D, D, 64, ar, am, vcu, G, wv0); if (!lastr) GRID_BAR(); } }
            GRID_BAR();
        } else {
            if (!bg_conv && layer == 1) { { TIDS(); convert_mats(args, 15, 16, lds, gw, NGW, wave, lane); } __syncthreads(); }
            for (int rep_ = 0; rep_ < REP_IN; ++rep_) {   unsigned char* ws = opq(args.ws); const ssq_t* ssq_mix = WSP(ssq_t, X_SSQ) + (size_t)(2 * layer) * MT;
                const float* pin = WSP(float, X_SSQP) + (size_t)(2 * layer) * MR * 4;
                const EpiArgs ar{ssq_mix, WSP(bf16, WS_BIG), nullptr, nullptr, nullptr, nullptr, 1.0f, pin, nullptr}, am{ssq_mix + MR, WSP(bf16, X_QKVM), nullptr, nullptr, nullptr, nullptr, 1.0f, nullptr, nullptr};
                do_gemm<K_QKV>(lds, WSP(bf16, WS_HB), WSP(bf16, X_HBM), WSP(bf16, WS_W + (j ? W_QKV1 : W_QKV0)), 3 * D, D, 192, ar, am, vcu, G, wv0); }
            GRID_BAR();
            for (int rep_ = 0; rep_ < REP_ATT; ++rep_) {   unsigned char* ws = opq(args.ws); const bf16 *QKV = WSP(bf16, WS_BIG), *QKVM = WSP(bf16, X_QKVM); bf16 *OB = WSP(bf16, WS_BIG + 96 * MiB), *OM = WSP(bf16, X_OM);
                { TIDS();
                  for (int it0 = vcu; it0 < 512; it0 += G) { const int it = (G == 256) ? ((vcu >> 5) * 64 + (it0 >> 8) * 32 + (vcu & 31)) : it0; const int pairq = it & 3, bh = it >> 2;
                    attn_wave(lds + wave * AW_BYTES, QKV, QKVM, OB, bh >> 4, bh & 15, 256 * pairq + 32 * wave, lane); attn_wave(lds + wave * AW_BYTES, QKV, QKVM, OB, bh >> 4, bh & 15, 256 * (7 - pairq) + 32 * wave, lane); }
                }
                { TIDS(); if (layer != DEPTH - 1 && vcu < NHEAD && wave == 0) attn_meta(lds + wave * AW_BYTES, QKVM, OM, vcu, lane); }
                __syncthreads(); }
            GRID_BAR();
            {   unsigned char* ws = opq(args.ws); ssq_t* ssq_mlp = WSP(ssq_t, X_SSQ) + (size_t)(2 * layer + 1) * MT;
                for (int rep_ = 0; rep_ < REP_RES; ++rep_) { const bool lastr = rep_ == REP_RES - 1; ssq_t* sq = lastr ? ssq_mlp : WSP(ssq_t, X_SSQ);
                float* pout = WSP(float, X_SSQP) + (size_t)(lastr ? (2 * layer + 1) : 0) * MR * 4;
                const EpiArgs ar{nullptr, WSP(bf16, WS_HB), nullptr, nullptr, nullptr, sq, 1.0f / REP_RES, nullptr, pout}, am{nullptr, WSP(bf16, X_HBM), nullptr, nullptr, nullptr, sq + MR, 1.0f / REP_RES, nullptr, nullptr};
                do_gemm<K_RESID>(lds, WSP(bf16, WS_BIG + 96 * MiB), WSP(bf16, X_OM), WSP(bf16, WS_W + (j ? W_AOUT1 : W_AOUT0)), D, D, layer == DEPTH - 1 ? 0 : 64, ar, am, vcu, G, wv0); if (!lastr) GRID_BAR(); } }
            GRID_BAR();
        }
        for (int rep_ = 0; rep_ < REP_UP; ++rep_) {   unsigned char* ws = opq(args.ws); const ssq_t* ssq_mlp = WSP(ssq_t, X_SSQ) + (size_t)(2 * layer + 1) * MT;
            const float* pin = WSP(float, X_SSQP) + (size_t)(2 * layer + 1) * MR * 4;
            const EpiArgs ar{ssq_mlp, WSP(bf16, WS_BIG), nullptr, nullptr, nullptr, nullptr, 1.0f, pin, nullptr}, am{ssq_mlp + MR, WSP(bf16, X_ACTM), nullptr, nullptr, nullptr, nullptr, 1.0f, nullptr, nullptr};
            do_gemm<K_UP>(lds, WSP(bf16, WS_HB), WSP(bf16, X_HBM), WSP(bf16, WS_W + (size_t)layer * 24 * MiB + 8 * MiB), FF, D, layer == DEPTH - 1 ? 0 : 256, ar, am, vcu, G, wv0); }
        GRID_BAR();
        {   unsigned char* ws = opq(args.ws); ssq_t* ssq_next = WSP(ssq_t, X_SSQ) + (size_t)(2 * layer + 2) * MT;
            for (int rep_ = 0; rep_ < REP_RES; ++rep_) { const bool lastr = rep_ == REP_RES - 1; ssq_t* sq = lastr ? ssq_next : WSP(ssq_t, X_SSQ);
            float* pout = WSP(float, X_SSQP) + (size_t)(lastr ? (2 * layer + 2) : 0) * MR * 4;
                const EpiArgs ar{nullptr, WSP(bf16, WS_HB), nullptr, nullptr, nullptr, sq, 1.0f / REP_RES, nullptr, pout}, am{nullptr, WSP(bf16, X_HBM), nullptr, nullptr, nullptr, sq + MR, 1.0f / REP_RES, nullptr, nullptr};
            do_gemm<K_RESID>(lds, WSP(bf16, WS_BIG), WSP(bf16, X_ACTM), WSP(bf16, WS_W + (layer == 3 ? W_DN3 : (size_t)layer * 24 * MiB + 16 * MiB)), D, FF, layer == DEPTH - 1 ? 0 : 64, ar, am, vcu, G, wv0); if (!lastr) GRID_BAR(); } }
        GRID_BAR();
    }
    {   TIDS(); unsigned char* ws = opq(args.ws); const float* ssqp = WSP(float, X_SSQP) + (size_t)8 * MR * 4; const float* final_norm = args.in[12]; const bf16* HB = WSP(bf16, WS_HB);
        f32x4 g[2][2];
#pragma unroll
        for (int jj = 0; jj < 2; ++jj) { g[jj][0] = *(const f32x4*)(final_norm + 8 * lane + 512 * jj); g[jj][1] = *(const f32x4*)(final_norm + 8 * lane + 512 * jj + 4); }
        for (int row = gw; row < MR; row += NGW) { const GAS f32x4* sp = (const GAS f32x4*)(ssqp + (size_t)row * 4); asm volatile("" : "+v"(sp));   const f32x4 sv = *sp; const float rs = rsqrtf(((sv[0] + sv[1]) + (sv[2] + sv[3])) * (1.0f / D) + RMS_EPS);
            float* p = args.out + (size_t)row * D; const bf16* hp = HB + (size_t)row * D;
#pragma unroll
            for (int jj = 0; jj < 2; ++jj) { const int c = 8 * lane + 512 * jj; const v4u w = *(const v4u*)(hp + c);
                f32x4 v0 = {__uint_as_float(w.x << 16), __uint_as_float(w.x & 0xffff0000u), __uint_as_float(w.y << 16), __uint_as_float(w.y & 0xffff0000u)};
                f32x4 v1 = {__uint_as_float(w.z << 16), __uint_as_float(w.z & 0xffff0000u), __uint_as_float(w.w << 16), __uint_as_float(w.w & 0xffff0000u)};
                v0 = v0 * rs * g[jj][0]; v1 = v1 * rs * g[jj][1]; __builtin_nontemporal_store(v0, (f32x4*)(p + c)); __builtin_nontemporal_store(v1, (f32x4*)(p + c + 4)); } }
    }
}

extern "C" void kernel_launch(void* const* d_in, const int* in_sizes, int n_in, void* d_out, int out_size, void* d_ws, size_t ws_size, hipStream_t stream) {
    static int grid = 0;
    if (grid == 0) {
        if (n_in != 13 || out_size != MR * D || ws_size < WS_END) { fprintf(stderr, "kernel_launch: unexpected shapes (n_in %d out %d ws %zu need %zu)\n", n_in, out_size, ws_size, (size_t)WS_END); grid = -1; return; }
        int dev = 0, cus = 0, per_cu = 0;
        hipGetDevice(&dev); hipDeviceGetAttribute(&cus, hipDeviceAttributeMultiprocessorCount, dev);
        if (hipFuncSetAttribute((const void*)fwd_megakernel, hipFuncAttributeMaxDynamicSharedMemorySize, LDS_BYTES) != hipSuccess) { fprintf(stderr, "kernel_launch: hipFuncSetAttribute failed\n"); grid = -1; return; }
        hipOccupancyMaxActiveBlocksPerMultiprocessor(&per_cu, (const void*)fwd_megakernel, NWAVES * 64, LDS_BYTES);
        (void)hipGetLastError();
        if (per_cu < 1) fprintf(stderr, "kernel_launch: occupancy query reports %d blocks per CU\n", per_cu);
        grid = cus > 0 ? cus : 256;
    }
    if (grid < 0) return;
    hipMemsetAsync((char*)d_ws + X_CTL, 0, CTL_BYTES, stream);
    Args a{};
    for (int i = 0; i < 13; ++i) a.in[i] = (const float*)d_in[i];
    a.out = (float*)d_out; a.ws = (unsigned char*)d_ws;
    void* kargs[] = {&a};
    hipError_t e = hipLaunchCooperativeKernel((const void*)fwd_megakernel, dim3(grid), dim3(NWAVES * 64), kargs, LDS_BYTES, stream);
    if (e != hipSuccess) fprintf(stderr, "cooperative launch failed: %s (grid %d)\n", hipGetErrorString(e), grid);
}
```
